# Optimizing an MI355X kernel written in HIP

```python
import math
import jax
import jax.numpy as jnp
from jax import lax
import numpy as np

D_MODEL = 1024
BATCH = 8
SEQ = 4096
DEPTH = 2
DEC_BATCH = 8
DEC_SEQ = 2048
PAST_LEN = 128

GRID_W = 64
BLOCK = 128
HEAD_DIM = 64
MIX_WIDTH = D_MODEL
EPS = 1e-6
ROPE_THETA = 10000.0

A_HEADS = 4
A_KV = 2
WINDOW = 128
B_HEADS = 4
B_Q_RANK = 256
B_KV_RANK = 128
B_NOPE = 64
B_ROPE = 32
B_V = 64
C_HEADS = 4
C_KV = 2
D_HEADS = 4
D_QK = 32
D_V = 64

N_ALIBI = A_HEADS + D_HEADS

D_FF = 2816
CONV_W = 3

IN_SIZES = (
    A_HEADS * HEAD_DIM, A_KV * HEAD_DIM, A_KV * HEAD_DIM,
    B_Q_RANK, B_KV_RANK, B_ROPE,
    C_HEADS * HEAD_DIM, C_KV * HEAD_DIM, C_KV * HEAD_DIM,
    D_HEADS * 2 * D_QK, D_HEADS * 2 * D_QK, D_HEADS * D_V,
)
IN_WIDTH = sum(IN_SIZES)

kernel_name = "hybrid_parallel_heads_encoder"


def rms_norm(x, g):
    xf = x.astype(jnp.float32)
    y = xf * lax.rsqrt(jnp.mean(xf * xf, axis=-1, keepdims=True) + EPS)
    return (y * g.astype(jnp.float32)).astype(x.dtype)


def rope(x, pos):
    dim = x.shape[-1]
    half = dim // 2
    inv = ROPE_THETA ** (-jnp.arange(half, dtype=jnp.float32) * 2.0 / dim)
    ang = pos[:, None] * inv[None, :]
    cos = jnp.cos(ang)[:, None, :]
    sin = jnp.sin(ang)[:, None, :]
    xf = x.astype(jnp.float32)
    x1, x2 = xf[..., :half], xf[..., half:]
    return jnp.concatenate([x1 * cos - x2 * sin, x2 * cos + x1 * sin], axis=-1).astype(x.dtype)


def sweep_query_blocks(fn, qs):
    bsz, s_len = qs[0].shape[:2]
    nb = s_len // BLOCK
    blocks = tuple(jnp.swapaxes(a.reshape(bsz, nb, BLOCK, *a.shape[2:]), 0, 1) for a in qs)
    out = lax.map(fn, (jnp.arange(nb), *blocks))
    out = jnp.swapaxes(out, 0, 1)
    return out.reshape(bsz, s_len, *out.shape[3:])


def windowed_sink_attention(q, k, v, sink, slopes):
    bsz, s_len = q.shape[:2]
    nb = s_len // BLOCK
    grp = A_HEADS // A_KV
    qb = q.reshape(bsz, nb, BLOCK, A_KV, grp, HEAD_DIM)

    def band(t):
        tp = jnp.pad(t, ((0, 0), (BLOCK, BLOCK), (0, 0), (0, 0))).reshape(bsz, nb + 2, BLOCK, A_KV, HEAD_DIM)
        return jnp.concatenate([tp[:, :-2], tp[:, 1:-1], tp[:, 2:]], axis=2)

    kb, vb = band(k), band(v)
    s = jnp.einsum("bnqkgd,bnjkd->bnkgqj", qb, kb, preferred_element_type=jnp.float32) * (HEAD_DIM ** -0.5)
    blk = jnp.arange(nb)
    qpos = blk[:, None] * BLOCK + jnp.arange(BLOCK)[None, :]
    kpos = (blk[:, None] - 1) * BLOCK + jnp.arange(3 * BLOCK)[None, :]
    dist = jnp.abs(qpos[:, :, None] - kpos[:, None, :])
    valid = (dist <= WINDOW) & (kpos >= 0)[:, None, :] & (kpos < s_len)[:, None, :]
    m_h = slopes.reshape(A_KV, grp)[None, None, :, :, None, None]
    s = s - m_h * dist.astype(jnp.float32)[None, :, None, None]
    s = jnp.where(valid[None, :, None, None], s, -jnp.inf)
    sink_l = sink.astype(jnp.float32).reshape(A_KV, grp)[None, None, :, :, None, None]
    m = jnp.maximum(jnp.max(s, axis=-1, keepdims=True), sink_l)
    p = jnp.exp(s - m)
    p = p / (jnp.sum(p, axis=-1, keepdims=True) + jnp.exp(sink_l - m))
    o = jnp.einsum("bnkgqj,bnjkd->bnqkgd", p.astype(v.dtype), vb)
    return o.reshape(bsz, s_len, A_HEADS * HEAD_DIM)


def latent_attention(c_q, c_kv, k_rope_raw, q_norm, w_q_up, kv_norm, w_kv_up, pos):
    bsz, s_len = c_q.shape[:2]
    q = (rms_norm(c_q, q_norm) @ w_q_up).reshape(bsz, s_len, B_HEADS, B_NOPE + B_ROPE)
    q_nope = q[..., :B_NOPE]
    q_rope = rope(q[..., B_NOPE:], pos)
    kv = (rms_norm(c_kv, kv_norm) @ w_kv_up).reshape(bsz, s_len, B_HEADS, B_NOPE + B_V)
    k_nope, vh = kv[..., :B_NOPE], kv[..., B_NOPE:]
    k_rope = rope(k_rope_raw[:, :, None, :], pos)[:, :, 0]
    scale = (B_NOPE + B_ROPE) ** -0.5

    def block(args):
        _, qn, qr = args
        s = (jnp.einsum("bqhd,bshd->bhqs", qn, k_nope, preferred_element_type=jnp.float32)
             + jnp.einsum("bqhd,bsd->bhqs", qr, k_rope, preferred_element_type=jnp.float32)) * scale
        p = jax.nn.softmax(s, axis=-1).astype(vh.dtype)
        return jnp.einsum("bhqs,bshd->bqhd", p, vh)

    o = sweep_query_blocks(block, (q_nope, q_rope))
    return o.reshape(bsz, s_len, B_HEADS * B_V)


def axial_rope_gqa(q, k, v, q_norm, k_norm, row_pos, col_pos):
    bsz, s_len = q.shape[:2]
    grp = C_HEADS // C_KV
    half = HEAD_DIM // 2

    def prep(t, n_h, g):
        t = rms_norm(t.reshape(bsz, s_len, n_h, HEAD_DIM), g)
        return jnp.concatenate([rope(t[..., :half], row_pos), rope(t[..., half:], col_pos)], axis=-1)

    qh = prep(q, C_HEADS, q_norm).reshape(bsz, s_len, C_KV, grp, HEAD_DIM)
    kh = prep(k, C_KV, k_norm)
    vh = v.reshape(bsz, s_len, C_KV, HEAD_DIM)
    scale = HEAD_DIM ** -0.5

    def block(args):
        _, qb = args
        s = jnp.einsum("bqkgd,bskd->bkgqs", qb, kh, preferred_element_type=jnp.float32) * scale
        p = jax.nn.softmax(s, axis=-1).astype(vh.dtype)
        return jnp.einsum("bkgqs,bskd->bqkgd", p, vh)

    o = sweep_query_blocks(block, (qh,))
    return o.reshape(bsz, s_len, C_HEADS * HEAD_DIM)


def differential_attention(q, k, v, lq1, lk1, lq2, lk2, sub_norm, slopes, lam_init):
    bsz, s_len = q.shape[:2]
    f32 = jnp.float32
    qh = q.reshape(bsz, s_len, D_HEADS, 2, D_QK)
    kh = k.reshape(bsz, s_len, D_HEADS, 2, D_QK)
    vh = v.reshape(bsz, s_len, D_HEADS, D_V)
    lam = (jnp.exp(jnp.sum(lq1.astype(f32) * lk1.astype(f32)))
           - jnp.exp(jnp.sum(lq2.astype(f32) * lk2.astype(f32))) + lam_init)
    kpos = jnp.arange(s_len)
    scale = D_QK ** -0.5

    def block(args):
        i, qb = args
        s = jnp.einsum("bqhcd,bshcd->bhcqs", qb, kh, preferred_element_type=f32) * scale
        qpos = i * BLOCK + jnp.arange(BLOCK)
        dist = jnp.abs(qpos[:, None] - kpos[None, :]).astype(f32)
        s = s - slopes[None, :, None, None, None] * dist
        p = jax.nn.softmax(s, axis=-1)
        a = p[:, :, 0] - lam * p[:, :, 1]
        return jnp.einsum("bhqs,bshd->bqhd", a.astype(vh.dtype), vh)

    o = sweep_query_blocks(block, (qh,))
    o = rms_norm(o, sub_norm) * (1.0 - lam_init)
    return o.reshape(bsz, s_len, D_HEADS * D_V)


def conv_gated_mlp(x, w_up, b_up, conv_w, conv_b, w_down):
    h = x @ w_up + b_up
    hp = jnp.pad(h, ((0, 0), (CONV_W // 2, CONV_W // 2), (0, 0)))
    h = conv_w[0] * hp[:, :-2] + conv_w[1] * hp[:, 1:-1] + conv_w[2] * hp[:, 2:] + conv_b
    a, b = jnp.split(h, 2, axis=-1)
    return (jax.nn.silu(a) * b) @ w_down


def trunk(x, g_attn, w_in, a_sink, b_q_norm, b_w_q_up, b_kv_norm, b_w_kv_up, c_q_norm, c_k_norm,
          d_lambda_q1, d_lambda_k1, d_lambda_q2, d_lambda_k2, d_sub_norm, w_out,
          g_ffn, w_up, b_up, conv_w, conv_b, w_down, g_final):
    bsz, s_len, _ = x.shape
    f32 = jnp.float32
    pos = jnp.arange(s_len, dtype=f32)
    rows = s_len // GRID_W
    row_pos = jnp.broadcast_to(jnp.arange(rows, dtype=f32)[:, None], (rows, GRID_W)).reshape(s_len)
    col_pos = jnp.broadcast_to(jnp.arange(GRID_W, dtype=f32)[None, :], (rows, GRID_W)).reshape(s_len)
    slopes = 2.0 ** (-8.0 * (jnp.arange(N_ALIBI, dtype=f32) + 1.0) / N_ALIBI)
    split_at = np.cumsum(IN_SIZES)[:-1].tolist()
    for l in range(DEPTH):
        h = rms_norm(x, g_attn[l]) @ w_in[l]
        aq, ak, av, bcq, bckv, bkr, cq, ck, cv, dq, dk, dv = jnp.split(h, split_at, axis=-1)
        o_a = windowed_sink_attention(
            aq.reshape(bsz, s_len, A_HEADS, HEAD_DIM),
            ak.reshape(bsz, s_len, A_KV, HEAD_DIM),
            av.reshape(bsz, s_len, A_KV, HEAD_DIM),
            a_sink[l], slopes[:A_HEADS])
        o_b = latent_attention(bcq, bckv, bkr, b_q_norm[l], b_w_q_up[l], b_kv_norm[l], b_w_kv_up[l], pos)
        o_c = axial_rope_gqa(cq, ck, cv, c_q_norm[l], c_k_norm[l], row_pos, col_pos)
        lam_init = 0.8 - 0.6 * math.exp(-0.3 * l)
        o_d = differential_attention(dq, dk, dv, d_lambda_q1[l], d_lambda_k1[l], d_lambda_q2[l], d_lambda_k2[l],
                                     d_sub_norm[l], slopes[A_HEADS:], lam_init)
        x = x + jnp.concatenate([o_a, o_b, o_c, o_d], axis=-1) @ w_out[l]
        x = x + conv_gated_mlp(rms_norm(x, g_ffn[l]), w_up[l], b_up[l], conv_w[l], conv_b[l], w_down[l])
    return rms_norm(x, g_final)


def setup_inputs(seed: int = 0) -> dict:
    key = jax.random.key(seed)
    ks = jax.random.split(key, 24)
    f32 = jnp.float32
    L = DEPTH

    def nrm(k, shape, scale):
        return jax.random.normal(k, shape, f32) * scale

    def gain(k, shape):
        return 1.0 + 0.05 * jax.random.normal(k, shape, f32)

    return {
        "x_prompt": nrm(ks[0], (BATCH, SEQ, D_MODEL), 1.0),
        "x_sample": nrm(ks[1], (DEC_BATCH, DEC_SEQ, D_MODEL), 1.0),
        "g_attn": gain(ks[2], (L, D_MODEL)),
        "w_in": nrm(ks[3], (L, D_MODEL, IN_WIDTH), D_MODEL ** -0.5),
        "a_sink": nrm(ks[4], (L, A_HEADS), 0.5),
        "b_q_norm": gain(ks[5], (L, B_Q_RANK)),
        "b_w_q_up": nrm(ks[6], (L, B_Q_RANK, B_HEADS * (B_NOPE + B_ROPE)), B_Q_RANK ** -0.5),
        "b_kv_norm": gain(ks[7], (L, B_KV_RANK)),
        "b_w_kv_up": nrm(ks[8], (L, B_KV_RANK, B_HEADS * (B_NOPE + B_V)), B_KV_RANK ** -0.5),
        "c_q_norm": gain(ks[9], (L, HEAD_DIM)),
        "c_k_norm": gain(ks[10], (L, HEAD_DIM)),
        "d_lambda_q1": nrm(ks[11], (L, D_QK), 0.1),
        "d_lambda_k1": nrm(ks[12], (L, D_QK), 0.1),
        "d_lambda_q2": nrm(ks[13], (L, D_QK), 0.1),
        "d_lambda_k2": nrm(ks[14], (L, D_QK), 0.1),
        "d_sub_norm": gain(ks[15], (L, D_V)),
        "w_out": nrm(ks[16], (L, MIX_WIDTH, D_MODEL), MIX_WIDTH ** -0.5),
        "g_ffn": gain(ks[17], (L, D_MODEL)),
        "w_up": nrm(ks[18], (L, D_MODEL, 2 * D_FF), D_MODEL ** -0.5),
        "b_up": nrm(ks[19], (L, 2 * D_FF), 0.02),
        "conv_w": nrm(ks[20], (L, CONV_W, 2 * D_FF), CONV_W ** -0.5),
        "conv_b": nrm(ks[21], (L, 2 * D_FF), 0.02),
        "w_down": nrm(ks[22], (L, D_FF, D_MODEL), D_FF ** -0.5),
        "g_final": gain(ks[23], (D_MODEL,)),
    }


def reference(x_prompt, x_sample, g_attn, w_in, a_sink, b_q_norm, b_w_q_up, b_kv_norm, b_w_kv_up,
              c_q_norm, c_k_norm, d_lambda_q1, d_lambda_k1, d_lambda_q2, d_lambda_k2, d_sub_norm, w_out,
              g_ffn, w_up, b_up, conv_w, conv_b, w_down, g_final):
    y_prompt = trunk(x_prompt, g_attn, w_in, a_sink, b_q_norm, b_w_q_up, b_kv_norm, b_w_kv_up,
                     c_q_norm, c_k_norm, d_lambda_q1, d_lambda_k1, d_lambda_q2, d_lambda_k2, d_sub_norm, w_out,
                     g_ffn, w_up, b_up, conv_w, conv_b, w_down, g_final)
    y_sample = trunk(x_sample, g_attn, w_in, a_sink, b_q_norm, b_w_q_up, b_kv_norm, b_w_kv_up,
                     c_q_norm, c_k_norm, d_lambda_q1, d_lambda_k1, d_lambda_q2, d_lambda_k2, d_sub_norm, w_out,
                     g_ffn, w_up, b_up, conv_w, conv_b, w_down, g_final)
    return (y_prompt, y_sample)
```

```cpp
#include <hip/hip_runtime.h>
#include <hip/hip_cooperative_groups.h>
#include <cstdio>
#include <cstdint>
namespace cg = cooperative_groups;

#ifndef SUBMASK
#define SUBMASK 0xffff
#endif
#ifndef SUB2B
#define SUB2B 7
#endif
#ifndef ATMODE
#define ATMODE 15
#endif
#ifndef PROBE_ATTN
#define PROBE_ATTN 1
#endif
#ifndef PROBE_GEMM
#define PROBE_GEMM 1
#endif
#ifndef PROBE_P0
#define PROBE_P0 1
#endif
#ifndef PROBE_BAR
#define PROBE_BAR 1
#endif
#ifndef PROBE_WHICH
#define PROBE_WHICH 15
#endif
#ifndef ONE_LAUNCH
#define ONE_LAUNCH 1
#endif

#define DI __device__ __forceinline__
typedef unsigned short bf16_t;
typedef short bf16x8 __attribute__((ext_vector_type(8)));
typedef short s16x4 __attribute__((ext_vector_type(4)));
typedef float f32x4 __attribute__((ext_vector_type(4)));
typedef float f32x16 __attribute__((ext_vector_type(16)));
typedef unsigned u32x4 __attribute__((ext_vector_type(4)));
typedef unsigned u32x2 __attribute__((ext_vector_type(2)));
typedef float f32x2_t __attribute__((ext_vector_type(2)));
typedef __bf16 bf16x2_t __attribute__((ext_vector_type(2)));

DI unsigned pk2(float lo, float hi) { f32x2_t v = {lo, hi}; bf16x2_t b = __builtin_convertvector(v, bf16x2_t); return __builtin_bit_cast(unsigned, b); }
#define GAS __attribute__((address_space(1)))
#define LAS __attribute__((address_space(3)))
template <class T> DI GAS T* gptr(T* p) { return (GAS T*)p; }
template <class T> DI const GAS T* gptr(const T* p) { return (const GAS T*)p; }
DI int lane_id() { int l = (int)__builtin_amdgcn_mbcnt_hi(~0u, __builtin_amdgcn_mbcnt_lo(~0u, 0u)); asm volatile("" : "+v"(l)); return l; }
DI float bflo(unsigned u) { return __uint_as_float(u << 16); }
DI float bfhi(unsigned u) { return __uint_as_float(u & 0xffff0000u); }

constexpr int DMODEL = 1024, MTOK = 49152, MPROMPT = 32768, SEQP = 4096, SEQS = 2048;
constexpr int INW = 2208, HW = 1792, DFF = 2816, DFF2 = 5632;
constexpr float EPS = 1e-6f;
constexpr float LOG2E = 1.4426950408889634f;
constexpr int NTHREADS = 512;
constexpr int NPHASES = 16;

constexpr size_t MiB = 1u << 20;
constexpr size_t WS_CTL = 0;
constexpr size_t WS_STAT = 1 * MiB;
constexpr size_t WS_CP = 1 * MiB + 1536 * 1024;
constexpr size_t WS_ROPE = 3 * MiB;
constexpr size_t WS_W = 4 * MiB;
constexpr size_t WL_IN = 0, WL_QUP = 4718592, WL_KUP = WL_QUP + 262144, WL_VUP = WL_KUP + 65536, WL_OUT = WL_VUP + 65536,
                 WL_UP = WL_OUT + 2097152, WL_DOWN = WL_UP + 11534336, WL_STRIDE = 24 * MiB;
static_assert(WL_DOWN + 5767168 <= WL_STRIDE, "weights per layer");
constexpr size_t WS_H = 52 * MiB;
constexpr size_t WS_VT = 220 * MiB;
constexpr size_t WS_G = 52 * MiB;
constexpr size_t WS_XB = 317 * MiB;
constexpr size_t WS_QB = WS_XB;
constexpr size_t WS_KBN = WS_XB + 36 * MiB;
constexpr size_t WS_ATT = 414 * MiB;
constexpr size_t WS_END = 510 * MiB;
constexpr int ST_ATTN0 = 0, ST_FFN0 = 1, ST_ATTN1 = 2, ST_FFN1 = 3, ST_SQQ = 4, ST_SQKV = 5;
constexpr int CW_ATTN_CTR = 0;
constexpr int CW_LAM = 600;
constexpr int CW_GBAR = 704;
constexpr int CW_XBAR = 4096;

constexpr int LDS_XCH = 131072, LDS_MISC = LDS_XCH + 4096, LDS_BYTES = LDS_MISC + 64;
struct Params {
    const float* in[24];
    float* out;
    unsigned char* ws;
    int ph_lo, ph_hi;
};

namespace pg8 {
#define PG8_LAS __attribute__((address_space(3)))
constexpr int BM = 256, BK = 64, HALF = 128, HTB = HALF * BK * 2  , STAGE_BYTES = 8 * HTB, NXCD = 8, WGM = 8;

__host__ __device__ __forceinline__ int lds_byte(int r, int c) { const int st = (r >> 4) * 2 + (c >> 5), rr = r & 15, cc = c & 31, ob = rr * 64 + cc * 2; return st * 1024 + (ob ^ (((ob >> 9) & 1) << 5)); }
__host__ __device__ __forceinline__ void stage_rc(int b, int& R, int& C) { const int st = b / 1024, sb = b % 1024, swz = sb ^ (((sb >> 9) & 1) << 5); R = (st >> 1) * 16 + swz / 64; C = (st & 1) * 32 + (swz % 64) / 2; }
__host__ __device__ __forceinline__ int perm32(int rho) { const int n = rho >> 4, i = rho & 15; return 8 * (i >> 2) + 4 * n + (i & 3); }
struct Unit { const char* A; const char* B; int pm, pn; };
template <bool PERMROWS, class Epi, class Sched>
__device__ __forceinline__ void gemm_phase(PG8_LAS unsigned char* lds, const int wid, const int K, const int lda, const int ldb, const Sched& S, const Epi& E) {
    constexpr bool ALIGN_EPI = true, SP2 = true;
    const int lane = lane_id(), tid = wid * 64 + lane, wr = wid >> 2, wc = wid & 3, fr = lane & 15, fq = lane >> 4;
    const int nt = K / BK;
    unsigned voffA[2], voffB[2];
#pragma unroll
    for (int i = 0; i < 2; ++i) { int R, C; stage_rc(tid * 16 + i * 8192, R, C); const int Rb = (R & ~31) + perm32(R & 31);
        const int Ra = PERMROWS ? (8 * (16 * (R >> 6) + (R & 15)) + ((R >> 4) & 3)) : R;
        voffA[i] = (unsigned)(Ra * lda + C) * 2u; voffB[i] = (unsigned)(Rb * ldb + C) * 2u; }
    const size_t kstep = (size_t)(BK * 2);
    const size_t hstepA = (size_t)(PERMROWS ? 4 : HALF) * lda * 2, hstepB = (size_t)HALF * ldb * 2;
    const unsigned ldsw = (unsigned)wid * 1024u;
    const int aoff = lds_byte(wr * 64 + fr, fq * 8), boff = lds_byte(wc * 32 + fr, fq * 8);
#define PG8_SA(b, h) (((b) * 2 + (h)) * HTB)
#define PG8_SB(b, h) ((4 + (b) * 2 + (h)) * HTB)
#define PG8_STAGE(bufoff, gbase, voff) do { _Pragma("unroll") for (int _i = 0; _i < 2; ++_i) \
        __builtin_amdgcn_global_load_lds((const unsigned*)((const char*)(gbase) + (voff)[_i]), (PG8_LAS unsigned*)(lds + (bufoff) + ldsw + _i * 8192), 16, 0, 0); } while (0)
#define PG8_LDA(dst, b, h) do { _Pragma("unroll") for (int m = 0; m < 4; ++m) _Pragma("unroll") for (int k = 0; k < 2; ++k) dst[m][k] = *(const PG8_LAS bf16x8*)(lds + PG8_SA(b, h) + aoff + m * 2048 + k * 1024); } while (0)
#define PG8_LDB(dst, b, h) do { _Pragma("unroll") for (int n = 0; n < 2; ++n) _Pragma("unroll") for (int k = 0; k < 2; ++k) dst[n][k] = *(const PG8_LAS bf16x8*)(lds + PG8_SB(b, h) + boff + n * 2048 + k * 1024); } while (0)
#define PG8_MMA(ai, bj, At, Bt) do { __builtin_amdgcn_s_setprio(1); _Pragma("unroll") for (int m = 0; m < 4; ++m) _Pragma("unroll") for (int n = 0; n < 2; ++n) _Pragma("unroll") for (int k = 0; k < 2; ++k) \
        acc[ai][bj][m][n] = __builtin_amdgcn_mfma_f32_16x16x32_bf16(Bt[n][k], At[m][k], acc[ai][bj][m][n], 0, 0, 0); __builtin_amdgcn_s_setprio(0); } while (0)
#define PG8_WAIT_V(n) asm volatile("s_waitcnt vmcnt(" #n ")" ::: "memory")
#define PG8_WAIT_L(n) asm volatile("s_waitcnt lgkmcnt(" #n ")" ::: "memory")
#define PG8_BAR __builtin_amdgcn_s_barrier()
#define PG8_SCHED __builtin_amdgcn_sched_barrier(0)
    Unit cur, nxt; int ui = 0;
    if (!S.next(0, cur)) return;
    f32x4 acc[2][2][4][2];
#pragma unroll
    for (int a = 0; a < 2; ++a)
#pragma unroll
        for (int b = 0; b < 2; ++b)
#pragma unroll
            for (int m = 0; m < 4; ++m)
#pragma unroll
                for (int n = 0; n < 2; ++n) acc[a][b][m][n] = (f32x4){0.f, 0.f, 0.f, 0.f};
    bf16x8 At[4][2], B0[2][2], B1[2][2];
    const char* cA = cur.A; const char* cB = cur.B;
    if constexpr (SP2) {
        PG8_STAGE(PG8_SB(0, 0), cB, voffB); PG8_STAGE(PG8_SB(0, 1), cB + hstepB, voffB); PG8_STAGE(PG8_SA(0, 0), cA, voffA); PG8_STAGE(PG8_SA(0, 1), cA + hstepA, voffA);
        if (wr == 1) PG8_BAR;
        PG8_WAIT_V(2); PG8_BAR;
        PG8_STAGE(PG8_SB(1, 0), cB + kstep, voffB); PG8_STAGE(PG8_SA(1, 0), cA + kstep, voffA); PG8_STAGE(PG8_SB(1, 1), cB + hstepB + kstep, voffB);
        PG8_WAIT_V(6); PG8_BAR;
    } else {
        PG8_STAGE(PG8_SB(0, 0), cB, voffB); PG8_STAGE(PG8_SA(0, 0), cA, voffA); PG8_STAGE(PG8_SB(0, 1), cB + hstepB, voffB); PG8_STAGE(PG8_SA(0, 1), cA + hstepA, voffA);
        if (wr == 1) PG8_BAR;
        PG8_WAIT_V(4); PG8_BAR;
        PG8_STAGE(PG8_SB(1, 0), cB + kstep, voffB); PG8_STAGE(PG8_SA(1, 0), cA + kstep, voffA); PG8_STAGE(PG8_SB(1, 1), cB + hstepB + kstep, voffB);
        PG8_WAIT_V(6); PG8_BAR;
    }
    for (;;) {
        const bool has_next = S.next(ui + 1, nxt);
        const char* nA = has_next ? nxt.A : cA; const char* nB = has_next ? nxt.B : cB;
#pragma unroll 1
        for (int t = 0; t < nt; t += 2) {
            const bool last = (t == nt - 2);
            const char* a1 = cA + (size_t)(t + 1) * kstep;
            const char* a2 = last ? nA : cA + (size_t)(t + 2) * kstep; const char* b2 = last ? nB : cB + (size_t)(t + 2) * kstep;
            const char* a3 = a2 + kstep; const char* b3 = b2 + kstep;
            if constexpr (SP2) {
            PG8_LDB(B0, 0, 0); PG8_LDB(B1, 0, 1); PG8_SCHED; PG8_LDA(At, 0, 0); PG8_STAGE(PG8_SA(1, 1), a1 + hstepA, voffA);
            PG8_WAIT_V(8); PG8_WAIT_L(0); PG8_BAR; PG8_MMA(0, 0, At, B0); PG8_MMA(0, 1, At, B1); PG8_BAR; PG8_SCHED;
            PG8_LDA(At, 0, 1); PG8_STAGE(PG8_SB(0, 0), b2, voffB); PG8_STAGE(PG8_SB(0, 1), b2 + hstepB, voffB); PG8_STAGE(PG8_SA(0, 0), a2, voffA);
            PG8_WAIT_V(8); PG8_WAIT_L(0); PG8_BAR; PG8_MMA(1, 0, At, B0); PG8_MMA(1, 1, At, B1); PG8_BAR; PG8_SCHED;
            PG8_LDB(B0, 1, 0); PG8_LDB(B1, 1, 1); PG8_SCHED; PG8_LDA(At, 1, 0); PG8_STAGE(PG8_SA(0, 1), a2 + hstepA, voffA);
            PG8_WAIT_V(8); PG8_WAIT_L(0); PG8_BAR; PG8_MMA(0, 0, At, B0); PG8_MMA(0, 1, At, B1); PG8_BAR; PG8_SCHED;
            PG8_LDA(At, 1, 1); PG8_STAGE(PG8_SB(1, 0), b3, voffB); PG8_STAGE(PG8_SB(1, 1), b3 + hstepB, voffB); PG8_STAGE(PG8_SA(1, 0), a3, voffA);
            PG8_WAIT_V(8); PG8_WAIT_L(0); PG8_BAR; PG8_MMA(1, 0, At, B0); PG8_MMA(1, 1, At, B1); PG8_BAR; PG8_SCHED;
            } else {
            PG8_LDB(B0, 0, 0); PG8_SCHED; PG8_LDA(At, 0, 0); PG8_STAGE(PG8_SA(1, 1), a1 + hstepA, voffA);
            PG8_WAIT_L(8); PG8_BAR; PG8_WAIT_L(0); PG8_MMA(0, 0, At, B0); PG8_BAR; PG8_SCHED;
            PG8_LDB(B1, 0, 1); PG8_STAGE(PG8_SB(0, 0), b2, voffB);
            PG8_BAR; PG8_WAIT_L(0); PG8_MMA(0, 1, At, B1); PG8_BAR;
            PG8_LDA(At, 0, 1); PG8_STAGE(PG8_SA(0, 0), a2, voffA);
            PG8_BAR; PG8_WAIT_L(0); PG8_MMA(1, 0, At, B0); PG8_BAR; PG8_SCHED;
            PG8_STAGE(PG8_SB(0, 1), b2 + hstepB, voffB);
            PG8_WAIT_V(6); PG8_BAR; PG8_MMA(1, 1, At, B1); PG8_BAR;
            PG8_LDB(B0, 1, 0); PG8_SCHED; PG8_LDA(At, 1, 0); PG8_STAGE(PG8_SA(0, 1), a2 + hstepA, voffA);
            PG8_WAIT_L(8); PG8_BAR; PG8_WAIT_L(0); PG8_MMA(0, 0, At, B0); PG8_BAR; PG8_SCHED;
            PG8_LDB(B1, 1, 1); PG8_STAGE(PG8_SB(1, 0), b3, voffB);
            PG8_BAR; PG8_WAIT_L(0); PG8_MMA(0, 1, At, B1); PG8_BAR;
            PG8_LDA(At, 1, 1); PG8_STAGE(PG8_SA(1, 0), a3, voffA);
            PG8_BAR; PG8_WAIT_L(0); PG8_MMA(1, 0, At, B0); PG8_BAR; PG8_SCHED;
            PG8_STAGE(PG8_SB(1, 1), b3 + hstepB, voffB);
            PG8_WAIT_V(6); PG8_BAR; PG8_MMA(1, 1, At, B1); PG8_BAR;
            }
        }
        if constexpr (ALIGN_EPI) { if (wr == 0) PG8_BAR; }
        E(acc, cur, wr, wc);
        if (!has_next) break;
#pragma unroll
        for (int a = 0; a < 2; ++a)
#pragma unroll
            for (int b = 0; b < 2; ++b)
#pragma unroll
                for (int m = 0; m < 4; ++m)
#pragma unroll
                    for (int n = 0; n < 2; ++n) acc[a][b][m][n] = (f32x4){0.f, 0.f, 0.f, 0.f};
        cur = nxt; cA = nA; cB = nB; ++ui;
        if constexpr (ALIGN_EPI) { if (wr == 1) PG8_BAR; }
    }
    PG8_WAIT_V(0);
    if constexpr (!ALIGN_EPI) { if (wr == 0) PG8_BAR; }
    PG8_BAR;
#undef PG8_SA
#undef PG8_SB
#undef PG8_STAGE
#undef PG8_LDA
#undef PG8_LDB
#undef PG8_MMA
#undef PG8_WAIT_V
#undef PG8_WAIT_L
#undef PG8_BAR
#undef PG8_SCHED
}
}

struct Order {
    int nM, nN, nwg, G, c;
    DI void init(int nM_, int nN_) { nM = nM_; nN = nN_; nwg = nM * nN; G = gridDim.x; c = blockIdx.x; }
    DI bool next(int i, int& pm, int& pn) const {
        const long L = (long)i * G + c; if (L >= nwg) return false;
        int wgid = (int)L; { const int q = nwg / 8, r = nwg % 8, xcd = wgid % 8, off = wgid / 8; wgid = (xcd < r ? xcd * (q + 1) : r * (q + 1) + (xcd - r) * q) + off; }
        const int nig = 8 * nN, gid = wgid / nig, fm = gid * 8, gsz = (nM - fm) < 8 ? (nM - fm) : 8;
        pm = fm + ((wgid % nig) % gsz); pn = (wgid % nig) / gsz; return true;
    }
};
struct SchedStd {
    Order o; const char* A; const char* B; long astride, bstride;
    DI bool next(int i, pg8::Unit& u) const { int pm, pn; if (!o.next(i, pm, pn)) return false; u.pm = pm; u.pn = pn; u.A = A + pm * astride; u.B = B + pn * bstride; return true; }
};
struct SchedInproj {
    Order o; const char* XB; const char* W;
    DI bool next(int i, pg8::Unit& u) const { int pm, pn; if (!o.next(i, pm, pn)) return false; u.pm = pm; u.pn = pn;
        const char* xt = XB + (long)pm * 256 * DMODEL * 2;
        if (pn < 7) { u.A = xt; u.B = W + (long)pn * 256 * DMODEL * 2; } else { u.A = W + (long)(1792 + 256 * (pn - 7)) * DMODEL * 2; u.B = xt; }
        return true; }
};
template <int MODE>
struct EpiScaleStore {
    bf16_t* O; int ldo; const float* rsum; float invn; int ncols; float* sq0; float* sq1;
    DI void operator()(f32x4 (&acc)[2][2][4][2], const pg8::Unit& u, int wr, int wc) const { (*this)(acc, 256 * u.pm, 256 * u.pn, wr, wc); }
    DI void operator()(f32x4 (&acc)[2][2][4][2], int row0, int col0, int wr, int wc) const {
        const int lane_ = lane_id(), fr = lane_ & 15, fq = lane_ >> 4;
        float cs[2][8];
        if (MODE == 1) {
#pragma unroll
            for (int bj = 0; bj < 2; ++bj)
#pragma unroll
                for (int j = 0; j < 8; ++j) cs[bj][j] = rsqrtf(gptr(rsum)[(unsigned)(col0 + 128 * bj + 32 * wc + 8 * fq + j)] * invn + EPS);
        }
#pragma unroll
        for (int ai = 0; ai < 2; ++ai)
#pragma unroll
            for (int m = 0; m < 4; ++m) {
                const int row = row0 + 128 * ai + 64 * wr + 16 * m + fr;
                float rs = 1.f, ssq = 0.f;
                if (MODE == 0) rs = rsqrtf(gptr(rsum)[(unsigned)row] * invn + EPS);
#pragma unroll
                for (int bj = 0; bj < 2; ++bj) {
                    const int col = col0 + 128 * bj + 32 * wc + 8 * fq;
                    if (col >= ncols) continue;
                    f32x4 v0 = acc[ai][bj][m][0], v1 = acc[ai][bj][m][1];
                    if (MODE == 0) { v0 = v0 * rs; v1 = v1 * rs; }
                    else { v0 = v0 * (f32x4){cs[bj][0], cs[bj][1], cs[bj][2], cs[bj][3]}; v1 = v1 * (f32x4){cs[bj][4], cs[bj][5], cs[bj][6], cs[bj][7]}; }
                    u32x4 w; w.x = pk2(v0[0], v0[1]); w.y = pk2(v0[2], v0[3]); w.z = pk2(v1[0], v1[1]); w.w = pk2(v1[2], v1[3]);
                    *(GAS u32x4*)(gptr(O) + (unsigned)(row * ldo + col)) = w;
                    if (MODE == 0 && sq0 && (col0 == 512 || (col0 == 768 && bj == 0)))
                        ssq += (v0[0] * v0[0] + v0[1] * v0[1]) + (v0[2] * v0[2] + v0[3] * v0[3]) + (v1[0] * v1[0] + v1[1] * v1[1]) + (v1[2] * v1[2] + v1[3] * v1[3]);
                }
                if (MODE == 0 && sq0 && (col0 == 512 || col0 == 768)) {
                    ssq += __shfl_xor(ssq, 16); ssq += __shfl_xor(ssq, 32);
                    if (fq == 0 && (col0 == 512 || wc < 4)) atomicAdd((col0 == 512 ? sq0 : sq1) + row, ssq);
                }
                asm volatile("" ::: "memory");
            }
    }
};

struct EpiInproj {
    EpiScaleStore<0> eh; EpiScaleStore<1> ev;
    DI void operator()(f32x4 (&acc)[2][2][4][2], const pg8::Unit& u, int wr, int wc) const {
        if (u.pn < 7) eh(acc, 256 * u.pm, 256 * u.pn, wr, wc); else ev(acc, 256 * (u.pn - 7), 256 * u.pm, wr, wc);
    }
};
DI int tok_pos(int row) { return row < MPROMPT ? (row & (SEQP - 1)) : (row & (SEQS - 1)); }

struct EpiQup {
    bf16_t* QB; const float* sq; const float* rope;
    DI void operator()(f32x4 (&acc)[2][2][4][2], const pg8::Unit& u, int wr, int wc) const { (*this)(acc, 256L * u.pm, 256L * u.pn, wr, wc); }
    DI void operator()(f32x4 (&acc)[2][2][4][2], long row0, long col0, int wr, int wc) const {
        const int lane_ = lane_id(), fr = lane_ & 15, fq = lane_ >> 4;
#pragma unroll
        for (int ai = 0; ai < 2; ++ai)
#pragma unroll
            for (int m = 0; m < 4; ++m) {
                const int row = (int)row0 + 128 * ai + 64 * wr + 16 * m + fr;
                const float rs = rsqrtf(gptr(sq)[(unsigned)row] * (1.f / 256.f) + EPS);
                const int pos = tok_pos(row);
#pragma unroll
                for (int bj = 0; bj < 2; ++bj) {
                    const int col = (int)col0 + 128 * bj + 32 * wc + 8 * fq;
                    if (col >= 384) continue;
                    const f32x4 v0 = acc[ai][bj][m][0] * rs, v1 = acc[ai][bj][m][1] * rs;
                    const int head = col / 96, w = col - head * 96;
                    if (w < 64) {
                        u32x4 o; o.x = pk2(v0[0], v0[1]); o.y = pk2(v0[2], v0[3]); o.z = pk2(v1[0], v1[1]); o.w = pk2(v1[2], v1[3]);
                        *(GAS u32x4*)(gptr(QB) + (unsigned)(row * 384 + col)) = o;
                    } else {
                        const int g = (w - 64) >> 3;
                        const GAS f32x4* t = (const GAS f32x4*)(gptr(rope) + (unsigned)((pos * 16 + 4 * g) * 2));
                        const f32x4 t0 = t[0], t1 = t[1];
                        const float c[4] = {t0[0], t0[2], t1[0], t1[2]}, s[4] = {t0[1], t0[3], t1[1], t1[3]};
                        float o1[4], o2[4];
#pragma unroll
                        for (int e = 0; e < 4; ++e) { o1[e] = v0[e] * c[e] - v1[e] * s[e]; o2[e] = v1[e] * c[e] + v0[e] * s[e]; }
                        u32x2 a, b; a.x = pk2(o1[0], o1[1]); a.y = pk2(o1[2], o1[3]); b.x = pk2(o2[0], o2[1]); b.y = pk2(o2[2], o2[3]);
                        GAS bf16_t* q = gptr(QB) + (unsigned)(row * 384 + head * 96 + 64 + 4 * g);
                        *(GAS u32x2*)q = a; *(GAS u32x2*)(q + 16) = b;
                    }
                }
                asm volatile("" ::: "memory");
            }
    }
};

struct EpiResid {
    const float* xo0; const float* xo1; float* out; bf16_t* XB; float* rsum;
    DI void operator()(f32x4 (&acc)[2][2][4][2], const pg8::Unit& u, int wr, int wc) const { (*this)(acc, 256L * u.pm, 256L * u.pn, wr, wc); }
    DI void operator()(f32x4 (&acc)[2][2][4][2], long row0, long col0, int wr, int wc) const {
        const int lane_ = lane_id(), fr = lane_ & 15, fq = lane_ >> 4;
#pragma unroll
        for (int ai = 0; ai < 2; ++ai)
#pragma unroll
            for (int m = 0; m < 4; ++m) {
                const int row = (int)row0 + 128 * ai + 64 * wr + 16 * m + fr;
                const GAS float* xo = row < MPROMPT ? gptr(xo0) + (unsigned)(row * DMODEL) : gptr(xo1) + (unsigned)((row - MPROMPT) * DMODEL);
                float ss = 0.f;
#pragma unroll
                for (int bj = 0; bj < 2; ++bj) {
                    const int col = (int)col0 + 128 * bj + 32 * wc + 8 * fq;
                    const f32x4 v0 = acc[ai][bj][m][0] + *(const GAS f32x4*)(xo + col), v1 = acc[ai][bj][m][1] + *(const GAS f32x4*)(xo + col + 4);
                    *(GAS f32x4*)(gptr(out) + (unsigned)(row * DMODEL + col)) = v0; *(GAS f32x4*)(gptr(out) + (unsigned)(row * DMODEL + col + 4)) = v1;
                    u32x4 w; w.x = pk2(v0[0], v0[1]); w.y = pk2(v0[2], v0[3]); w.z = pk2(v1[0], v1[1]); w.w = pk2(v1[2], v1[3]);
                    *(GAS u32x4*)(gptr(XB) + (unsigned)(row * DMODEL + col)) = w;
                    ss += (v0[0] * v0[0] + v0[1] * v0[1]) + (v0[2] * v0[2] + v0[3] * v0[3]) + (v1[0] * v1[0] + v1[1] * v1[1]) + (v1[2] * v1[2] + v1[3] * v1[3]);
                }
                if (rsum) {
                    ss += __shfl_xor(ss, 16); ss += __shfl_xor(ss, 32);
                    if (fq == 0) atomicAdd(rsum + row, ss);
                }
                asm volatile("" ::: "memory");
            }
    }
};

DI bool seq_start(int g) { return g < MPROMPT ? ((g & (SEQP - 1)) == 0) : ((g & (SEQS - 1)) == 0); }
DI bool seq_end(int g) { return g < MPROMPT ? ((g & (SEQP - 1)) == SEQP - 1) : ((g & (SEQS - 1)) == SEQS - 1); }

struct EpiConvGate {
    bf16_t* G; const float* rsum; const float* bup; const float* cp; float* xch;
    DI void operator()(f32x4 (&acc)[2][2][4][2], const pg8::Unit& u, int wr, int wc) const { (*this)(acc, u.pm, u.pn, wr, wc); }
    DI void operator()(f32x4 (&acc)[2][2][4][2], int pm, int pn, int wr, int wc) const {
        const int lane_ = lane_id(), fr = lane_ & 15, fq = lane_ >> 4;
        const int G16 = 16 * wr + fr;
        const int g0 = 254 * pm - 1 + 8 * G16;
        const int ffb = 128 * pn + 32 * wc + 8 * fq;
        unsigned stm = 0u, enm = 0u;
#pragma unroll
        for (int jj = 0; jj < 8; ++jj) {
            const int g = g0 + jj; const bool ok = (g >= 0 && g < MTOK);
            const float rs = ok ? rsqrtf(gptr(rsum)[(unsigned)(ok ? g : 0)] * (1.f / 1024.f) + EPS) : 0.f;
            stm |= (seq_start(g) ? 1u : 0u) << jj; enm |= (seq_end(g) ? 1u : 0u) << jj;
#pragma unroll
            for (int bj = 0; bj < 2; ++bj)
#pragma unroll
                for (int n = 0; n < 2; ++n) {
                    const f32x4 bias = *(const GAS f32x4*)(gptr(bup) + (unsigned)(bj * DFF + ffb + 4 * n));
                    f32x4 h = acc[jj >> 2][bj][jj & 3][n] * rs + bias;
                    if (!ok) h = (f32x4){0.f, 0.f, 0.f, 0.f};
                    acc[jj >> 2][bj][jj & 3][n] = h;
                }
        }
        LAS f32x4* x0 = (LAS f32x4*)xch;
        if (fr == 15) {
#pragma unroll
            for (int bj = 0; bj < 2; ++bj)
#pragma unroll
                for (int n = 0; n < 2; ++n) x0[(((0 * 2 + wr) * 4 + wc) * 4 + fq) * 4 + bj * 2 + n] = acc[1][bj][3][n];
        }
        if (fr == 0) {
#pragma unroll
            for (int bj = 0; bj < 2; ++bj)
#pragma unroll
                for (int n = 0; n < 2; ++n) x0[(((1 * 2 + wr) * 4 + wc) * 4 + fq) * 4 + bj * 2 + n] = acc[0][bj][0][n];
        }
        asm volatile("s_waitcnt lgkmcnt(0)" ::: "memory"); __builtin_amdgcn_s_barrier(); asm volatile("" ::: "memory");
#pragma unroll
        for (int n = 0; n < 2; ++n) {
            unsigned ci = (unsigned)((ffb + 4 * n) * 2); asm volatile("" : "+v"(ci));
            const GAS f32x4* cpp = (const GAS f32x4*)gptr(cp) + ci;
            f32x4 prm[4][2];
#pragma unroll
            for (int e = 0; e < 4; ++e) { prm[e][0] = cpp[2 * e]; prm[e][1] = cpp[2 * e + 1]; }
            f32x4 pv[2], nx[2];
#pragma unroll
            for (int bj = 0; bj < 2; ++bj) {
#pragma unroll
                for (int e = 0; e < 4; ++e) { pv[bj][e] = __shfl_up(acc[1][bj][3][n][e], 1, 16); nx[bj][e] = __shfl_down(acc[0][bj][0][n][e], 1, 16); }
                if (fr == 0 && wr == 1) pv[bj] = x0[(((0 * 2 + 0) * 4 + wc) * 4 + fq) * 4 + bj * 2 + n];
                if (fr == 15 && wr == 0) nx[bj] = x0[(((1 * 2 + 1) * 4 + wc) * 4 + fq) * 4 + bj * 2 + n];
            }
#pragma unroll
            for (int hf = 0; hf < 2; ++hf) {
                unsigned opk[4][2];
#pragma unroll
                for (int ep = 0; ep < 2; ++ep) {
                    float val[4][2];
#pragma unroll
                    for (int eh = 0; eh < 2; ++eh) {
                        const int e = 2 * ep + eh;
                        const f32x4 pa = prm[e][0], pb = prm[e][1];
                        const float w0a = pa[0], w1a = pa[1], w2a = pa[2], ca0 = pa[3];
                        const float w0b = pb[0], w1b = pb[1], w2b = pb[2], cb0 = pb[3];
#pragma unroll
                        for (int j4 = 0; j4 < 4; ++j4) {
                            const int jj = 4 * hf + j4;
                            float hpa = jj == 0 ? pv[0][e] : acc[(jj - 1) >> 2][0][(jj - 1) & 3][n][e];
                            float hpb = jj == 0 ? pv[1][e] : acc[(jj - 1) >> 2][1][(jj - 1) & 3][n][e];
                            float hna = jj == 7 ? nx[0][e] : acc[(jj + 1) >> 2][0][(jj + 1) & 3][n][e];
                            float hnb = jj == 7 ? nx[1][e] : acc[(jj + 1) >> 2][1][(jj + 1) & 3][n][e];
                            if ((stm >> jj) & 1u) { hpa = 0.f; hpb = 0.f; }
                            if ((enm >> jj) & 1u) { hna = 0.f; hnb = 0.f; }
                            const float ha = acc[jj >> 2][0][jj & 3][n][e], hb = acc[jj >> 2][1][jj & 3][n][e];
                            const float ca = w0a * hpa + w1a * ha + w2a * hna + ca0;
                            const float cbv = w0b * hpb + w1b * hb + w2b * hnb + cb0;
                            val[j4][eh] = ca * __builtin_amdgcn_rcpf(1.f + __expf(-ca)) * cbv;
                        }
                    }
#pragma unroll
                    for (int j4 = 0; j4 < 4; ++j4) opk[j4][ep] = pk2(val[j4][0], val[j4][1]);
                }
#pragma unroll
                for (int j4 = 0; j4 < 4; ++j4) {
                    const int jj = 4 * hf + j4;
                    const int T = 8 * G16 + jj; const int g = g0 + jj;
                    if (T >= 1 && T <= 254 && g < MTOK) { u32x2 w; w.x = opk[j4][0]; w.y = opk[j4][1]; *(GAS u32x2*)(gptr(G) + ((unsigned)g * (unsigned)DFF + (unsigned)(ffb + 4 * n))) = w; }
                }
                asm volatile("" ::: "memory");
            }
            asm volatile("" ::: "memory");
        }
        asm volatile("s_waitcnt lgkmcnt(0)" ::: "memory"); __builtin_amdgcn_s_barrier(); asm volatile("" ::: "memory");
    }
};

constexpr int AT_KLD = 104, AT_VLD = 72;
constexpr int AT_KBUF = 64 * AT_KLD * 2, AT_VBUF = 64 * AT_VLD * 2;
constexpr int AT_VOFF = 2 * AT_KBUF, AT_BYTES = AT_VOFF + 2 * AT_VBUF;
struct AttnArgs {
    const bf16_t* Q; int ldq; const bf16_t* K; int ldk; const bf16_t* K2; int ldk2; const bf16_t* VT; bf16_t* O;
    long row0; int S; int q0; float slope2; float sink2; float lam; float post; const float* subn;
};
DI int crow(int r, int hi) { return (r & 3) + 8 * (r >> 2) + 4 * hi; }
constexpr float NEG_BIG = -1e30f;

#define SB() do {} while (0)
template <int NQ, int D0, bool ALIBI, bool WINDOW>
DI void attn_tile(const bf16x8* qf, const LAS unsigned char* kb, const LAS unsigned char* vbuf, float& mhat, f32x16& negm, float& l, f32x16 (&o)[2], float dq, float slope2, int r32, int hi, const bool first) {
    bf16x8 kf[2][NQ];
#pragma unroll
    for (int d0 = 0; d0 < NQ; ++d0)
#pragma unroll
        for (int blk = 0; blk < 2; ++blk) kf[blk][d0] = *(const LAS bf16x8*)(kb + ((32 * blk + r32) * AT_KLD + 16 * (D0 + d0) + 8 * hi) * 2);
    SB();
    f32x16 s[2];
#pragma unroll
    for (int d0 = 0; d0 < NQ; ++d0)
#pragma unroll
        for (int blk = 0; blk < 2; ++blk) s[blk] = __builtin_amdgcn_mfma_f32_32x32x16_bf16(kf[blk][d0], qf[D0 + d0], d0 == 0 ? negm : s[blk], 0, 0, 0);
    SB();
    bf16x8 vA[2][2], vB[2][2];
#pragma unroll
    for (int kk = 0; kk < 2; ++kk)
#pragma unroll
        for (int d = 0; d < 2; ++d) {
            vA[d][kk] = *(const LAS bf16x8*)(vbuf + ((32 * d + r32) * AT_VLD + 16 * kk + 8 * hi) * 2);
        }
    if (ALIBI || WINDOW) {
#pragma unroll
        for (int blk = 0; blk < 2; ++blk)
#pragma unroll
            for (int r = 0; r < 16; ++r) {
                const float dist = fabsf(dq - (float)(32 * blk + (r & 3) + 8 * (r >> 2)));
                float v = s[blk][r];
                if (ALIBI) v = v - slope2 * dist;
                if (WINDOW) v = dist > 128.f ? NEG_BIG : v;
                s[blk][r] = v;
            }
    }
    float mx = s[0][0];
#pragma unroll
    for (int r = 1; r < 16; ++r) mx = fmaxf(mx, s[0][r]);
#pragma unroll
    for (int r = 0; r < 16; ++r) mx = fmaxf(mx, s[1][r]);
    mx = fmaxf(mx, __shfl_xor(mx, 32));
    if (first || __any(mx > 8.f)) {
        const float dl = first ? mx : fmaxf(mx, 0.f);
        mhat += dl;
#pragma unroll
        for (int blk = 0; blk < 2; ++blk)
#pragma unroll
            for (int r = 0; r < 16; ++r) s[blk][r] -= dl;
#pragma unroll
        for (int r = 0; r < 16; ++r) negm[r] = -mhat;
        const float f = first ? 1.f : __builtin_amdgcn_exp2f(-dl);
        l *= f;
#pragma unroll
        for (int d = 0; d < 2; ++d)
#pragma unroll
            for (int r = 0; r < 16; ++r) o[d][r] *= f;
    }
    float ps = 0.f;
#pragma unroll
    for (int blk = 0; blk < 2; ++blk)
#pragma unroll
        for (int r = 0; r < 16; ++r) { const float p = __builtin_amdgcn_exp2f(s[blk][r]); s[blk][r] = p; ps += p; }
    l += ps;
    bf16x8 pf[2][2];
#pragma unroll
    for (int blk = 0; blk < 2; ++blk)
#pragma unroll
        for (int kk = 0; kk < 2; ++kk) {
            u32x4 pw; pw.x = pk2(s[blk][8 * kk + 0], s[blk][8 * kk + 1]); pw.y = pk2(s[blk][8 * kk + 2], s[blk][8 * kk + 3]);
            pw.z = pk2(s[blk][8 * kk + 4], s[blk][8 * kk + 5]); pw.w = pk2(s[blk][8 * kk + 6], s[blk][8 * kk + 7]);
            pf[blk][kk] = __builtin_bit_cast(bf16x8, pw);
        }
    SB();
#pragma unroll
    for (int kk = 0; kk < 2; ++kk)
#pragma unroll
        for (int d = 0; d < 2; ++d) {
            vB[d][kk] = *(const LAS bf16x8*)(vbuf + ((32 * d + r32) * AT_VLD + 32 + 16 * kk + 8 * hi) * 2);
        }
#pragma unroll
    for (int kk = 0; kk < 2; ++kk)
#pragma unroll
        for (int d = 0; d < 2; ++d) o[d] = __builtin_amdgcn_mfma_f32_32x32x16_bf16(vA[d][kk], pf[0][kk], o[d], 0, 0, 0);
    SB();
#pragma unroll
    for (int kk = 0; kk < 2; ++kk)
#pragma unroll
        for (int d = 0; d < 2; ++d) o[d] = __builtin_amdgcn_mfma_f32_32x32x16_bf16(vB[d][kk], pf[1][kk], o[d], 0, 0, 0);
    SB();
}


template <int NQ, int D0, bool ALIBI, bool WINDOW>
DI void attn_tile_x(const bf16x8* qf, const LAS unsigned char* kb, f32x16 (&s)[2], float& mhat, f32x16& negm, float& l, f32x16 (&o)[2], float dq, float slope2, int r32, int hi, const bool first) {
    bf16x8 kf[2][NQ];
#pragma unroll
    for (int d0 = 0; d0 < NQ; ++d0)
#pragma unroll
        for (int blk = 0; blk < 2; ++blk) kf[blk][d0] = *(const LAS bf16x8*)(kb + ((32 * blk + r32) * AT_KLD + 16 * (D0 + d0) + 8 * hi) * 2);
    SB();
#pragma unroll
    for (int d0 = 0; d0 < NQ; ++d0)
#pragma unroll
        for (int blk = 0; blk < 2; ++blk) s[blk] = __builtin_amdgcn_mfma_f32_32x32x16_bf16(kf[blk][d0], qf[D0 + d0], d0 == 0 ? negm : s[blk], 0, 0, 0);
    SB();
    if (ALIBI || WINDOW) {
#pragma unroll
        for (int blk = 0; blk < 2; ++blk)
#pragma unroll
            for (int r = 0; r < 16; ++r) {
                const float dist = fabsf(dq - (float)(32 * blk + (r & 3) + 8 * (r >> 2)));
                float v = s[blk][r];
                if (ALIBI) v = v - slope2 * dist;
                if (WINDOW) v = dist > 128.f ? NEG_BIG : v;
                s[blk][r] = v;
            }
    }
    float mx = s[0][0];
#pragma unroll
    for (int r = 1; r < 16; ++r) mx = fmaxf(mx, s[0][r]);
#pragma unroll
    for (int r = 0; r < 16; ++r) mx = fmaxf(mx, s[1][r]);
    mx = fmaxf(mx, __shfl_xor(mx, 32));
    if (first || __any(mx > 8.f)) {
        const float dl = first ? mx : fmaxf(mx, 0.f);
        mhat += dl;
#pragma unroll
        for (int blk = 0; blk < 2; ++blk)
#pragma unroll
            for (int r = 0; r < 16; ++r) s[blk][r] -= dl;
#pragma unroll
        for (int r = 0; r < 16; ++r) negm[r] = -mhat;
        const float f = first ? 1.f : __builtin_amdgcn_exp2f(-dl);
        l *= f;
#pragma unroll
        for (int d = 0; d < 2; ++d)
#pragma unroll
            for (int r = 0; r < 16; ++r) o[d][r] *= f;
    }
#pragma unroll
    for (int blk = 0; blk < 2; ++blk)
#pragma unroll
        for (int r = 0; r < 16; ++r) s[blk][r] = __builtin_amdgcn_exp2f(s[blk][r]);
}
DI void attn_tile_y(const f32x16 (&s)[2], const LAS unsigned char* vbuf, float& l, f32x16 (&o)[2], int r32, int hi) {
    bf16x8 vA[2][2], vB[2][2];
#pragma unroll
    for (int kk = 0; kk < 2; ++kk)
#pragma unroll
        for (int d = 0; d < 2; ++d) vA[d][kk] = *(const LAS bf16x8*)(vbuf + ((32 * d + r32) * AT_VLD + 16 * kk + 8 * hi) * 2);
    float ps = 0.f;
#pragma unroll
    for (int blk = 0; blk < 2; ++blk)
#pragma unroll
        for (int r = 0; r < 16; ++r) ps += s[blk][r];
    l += ps;
    bf16x8 pf[2][2];
#pragma unroll
    for (int blk = 0; blk < 2; ++blk)
#pragma unroll
        for (int kk = 0; kk < 2; ++kk) {
            u32x4 pw; pw.x = pk2(s[blk][8 * kk + 0], s[blk][8 * kk + 1]); pw.y = pk2(s[blk][8 * kk + 2], s[blk][8 * kk + 3]);
            pw.z = pk2(s[blk][8 * kk + 4], s[blk][8 * kk + 5]); pw.w = pk2(s[blk][8 * kk + 6], s[blk][8 * kk + 7]);
            pf[blk][kk] = __builtin_bit_cast(bf16x8, pw);
        }
    SB();
#pragma unroll
    for (int kk = 0; kk < 2; ++kk)
#pragma unroll
        for (int d = 0; d < 2; ++d) vB[d][kk] = *(const LAS bf16x8*)(vbuf + ((32 * d + r32) * AT_VLD + 32 + 16 * kk + 8 * hi) * 2);
#pragma unroll
    for (int kk = 0; kk < 2; ++kk)
#pragma unroll
        for (int d = 0; d < 2; ++d) o[d] = __builtin_amdgcn_mfma_f32_32x32x16_bf16(vA[d][kk], pf[0][kk], o[d], 0, 0, 0);
    SB();
#pragma unroll
    for (int kk = 0; kk < 2; ++kk)
#pragma unroll
        for (int d = 0; d < 2; ++d) o[d] = __builtin_amdgcn_mfma_f32_32x32x16_bf16(vB[d][kk], pf[1][kk], o[d], 0, 0, 0);
    SB();
}

template <int D0>
DI void attn_tile_d(const bf16x8* qf, const LAS unsigned char* kb, const LAS unsigned char* vbuf, float& mhat, float& l, f32x16 (&o)[2], const f32x16& pat,
                    const bool diag, const float adj, const float adj32, float dq, float slope2, int r32, int hi, const bool first) {
    __builtin_amdgcn_sched_barrier(0);
    bf16x8 kf[2][2];
#pragma unroll
    for (int d0 = 0; d0 < 2; ++d0)
#pragma unroll
        for (int blk = 0; blk < 2; ++blk) kf[blk][d0] = *(const LAS bf16x8*)(kb + ((32 * blk + r32) * AT_KLD + 16 * (D0 + d0) + 8 * hi) * 2);
    f32x16 s[2];
    if (!diag) {
#pragma unroll
        for (int d0 = 0; d0 < 2; ++d0)
#pragma unroll
            for (int blk = 0; blk < 2; ++blk) s[blk] = __builtin_amdgcn_mfma_f32_32x32x16_bf16(kf[blk][d0], qf[D0 + d0], d0 == 0 ? pat : s[blk], 0, 0, 0);
        const float sref0 = mhat - adj, sref1 = sref0 - adj32;
#pragma unroll
        for (int r = 0; r < 16; ++r) { s[0][r] -= sref0; s[1][r] -= sref1; }
    } else {
        const f32x16 zero16 = {0.f, 0.f, 0.f, 0.f, 0.f, 0.f, 0.f, 0.f, 0.f, 0.f, 0.f, 0.f, 0.f, 0.f, 0.f, 0.f};
#pragma unroll
        for (int d0 = 0; d0 < 2; ++d0)
#pragma unroll
            for (int blk = 0; blk < 2; ++blk) s[blk] = __builtin_amdgcn_mfma_f32_32x32x16_bf16(kf[blk][d0], qf[D0 + d0], d0 == 0 ? zero16 : s[blk], 0, 0, 0);
#pragma unroll
        for (int blk = 0; blk < 2; ++blk)
#pragma unroll
            for (int r = 0; r < 16; ++r) s[blk][r] = s[blk][r] - slope2 * fabsf(dq - (float)(32 * blk + (r & 3) + 8 * (r >> 2))) - mhat;
    }
    float mx = s[0][0];
#pragma unroll
    for (int r = 1; r < 16; ++r) mx = fmaxf(mx, s[0][r]);
#pragma unroll
    for (int r = 0; r < 16; ++r) mx = fmaxf(mx, s[1][r]);
    mx = fmaxf(mx, __shfl_xor(mx, 32));
    if (first || __any(mx > 8.f)) {
        const float dl = first ? mx : fmaxf(mx, 0.f);
        mhat += dl;
#pragma unroll
        for (int blk = 0; blk < 2; ++blk)
#pragma unroll
            for (int r = 0; r < 16; ++r) s[blk][r] -= dl;
        const float f = first ? 1.f : __builtin_amdgcn_exp2f(-dl);
        l *= f;
#pragma unroll
        for (int d = 0; d < 2; ++d)
#pragma unroll
            for (int r = 0; r < 16; ++r) o[d][r] *= f;
    }
    float ps = 0.f;
#pragma unroll
    for (int blk = 0; blk < 2; ++blk)
#pragma unroll
        for (int r = 0; r < 16; ++r) { const float p = __builtin_amdgcn_exp2f(s[blk][r]); s[blk][r] = p; ps += p; }
    l += ps;
    bf16x8 pf[2][2];
#pragma unroll
    for (int blk = 0; blk < 2; ++blk)
#pragma unroll
        for (int kk = 0; kk < 2; ++kk) {
            u32x4 pw; pw.x = pk2(s[blk][8 * kk + 0], s[blk][8 * kk + 1]); pw.y = pk2(s[blk][8 * kk + 2], s[blk][8 * kk + 3]);
            pw.z = pk2(s[blk][8 * kk + 4], s[blk][8 * kk + 5]); pw.w = pk2(s[blk][8 * kk + 6], s[blk][8 * kk + 7]);
            pf[blk][kk] = __builtin_bit_cast(bf16x8, pw);
        }
    bf16x8 vA[2][2], vB[2][2];
#pragma unroll
    for (int kk = 0; kk < 2; ++kk)
#pragma unroll
        for (int d = 0; d < 2; ++d) vA[d][kk] = *(const LAS bf16x8*)(vbuf + ((32 * d + r32) * AT_VLD + 16 * kk + 8 * hi) * 2);
#pragma unroll
    for (int kk = 0; kk < 2; ++kk)
#pragma unroll
        for (int d = 0; d < 2; ++d) vB[d][kk] = *(const LAS bf16x8*)(vbuf + ((32 * d + r32) * AT_VLD + 32 + 16 * kk + 8 * hi) * 2);
#pragma unroll
    for (int kk = 0; kk < 2; ++kk)
#pragma unroll
        for (int d = 0; d < 2; ++d) o[d] = __builtin_amdgcn_mfma_f32_32x32x16_bf16(vA[d][kk], pf[0][kk], o[d], 0, 0, 0);
#pragma unroll
    for (int kk = 0; kk < 2; ++kk)
#pragma unroll
        for (int d = 0; d < 2; ++d) o[d] = __builtin_amdgcn_mfma_f32_32x32x16_bf16(vB[d][kk], pf[1][kk], o[d], 0, 0, 0);
}

DI void attn_d_post(f32x16 (&s)[2], float& mhat, float& l, f32x16 (&o)[2], bf16x8 (&pf)[2][2], const bool diag, const float adj, const float adj32, const float dq, const float slope2, const bool first) {
    if (!diag) {
        const float sref0 = mhat - adj, sref1 = sref0 - adj32;
#pragma unroll
        for (int r = 0; r < 16; ++r) { s[0][r] -= sref0; s[1][r] -= sref1; }
    } else {
#pragma unroll
        for (int blk = 0; blk < 2; ++blk)
#pragma unroll
            for (int r = 0; r < 16; ++r) s[blk][r] = s[blk][r] - slope2 * fabsf(dq - (float)(32 * blk + (r & 3) + 8 * (r >> 2))) - mhat;
    }
    float mx = s[0][0];
#pragma unroll
    for (int r = 1; r < 16; ++r) mx = fmaxf(mx, s[0][r]);
#pragma unroll
    for (int r = 0; r < 16; ++r) mx = fmaxf(mx, s[1][r]);
    mx = fmaxf(mx, __shfl_xor(mx, 32));
    if (first || __any(mx > 8.f)) {
        const float dl = first ? mx : fmaxf(mx, 0.f);
        mhat += dl;
#pragma unroll
        for (int blk = 0; blk < 2; ++blk)
#pragma unroll
            for (int r = 0; r < 16; ++r) s[blk][r] -= dl;
        const float f = first ? 1.f : __builtin_amdgcn_exp2f(-dl);
        l *= f;
#pragma unroll
        for (int d = 0; d < 2; ++d)
#pragma unroll
            for (int r = 0; r < 16; ++r) o[d][r] *= f;
    }
    float ps = 0.f;
#pragma unroll
    for (int blk = 0; blk < 2; ++blk)
#pragma unroll
        for (int r = 0; r < 16; ++r) { const float p = __builtin_amdgcn_exp2f(s[blk][r]); s[blk][r] = p; ps += p; }
    l += ps;
#pragma unroll
    for (int blk = 0; blk < 2; ++blk)
#pragma unroll
        for (int kk = 0; kk < 2; ++kk) {
            u32x4 pw; pw.x = pk2(s[blk][8 * kk + 0], s[blk][8 * kk + 1]); pw.y = pk2(s[blk][8 * kk + 2], s[blk][8 * kk + 3]);
            pw.z = pk2(s[blk][8 * kk + 4], s[blk][8 * kk + 5]); pw.w = pk2(s[blk][8 * kk + 6], s[blk][8 * kk + 7]);
            pf[blk][kk] = __builtin_bit_cast(bf16x8, pw);
        }
}
DI void attn_tile_d2(const bf16x8* qf, const LAS unsigned char* kb, const LAS unsigned char* vbuf, float& m0, float& l0, f32x16 (&o0)[2], float& m1, float& l1, f32x16 (&o1)[2],
                     const f32x16& pat, const bool diag, const float adj, const float adj32, float dq, float slope2, int r32, int hi, const bool first) {
    f32x16 s0[2], s1[2];
    {
        bf16x8 kf[2][4];
#pragma unroll
        for (int d0 = 0; d0 < 4; ++d0)
#pragma unroll
            for (int blk = 0; blk < 2; ++blk) kf[blk][d0] = *(const LAS bf16x8*)(kb + ((32 * blk + r32) * AT_KLD + 16 * d0 + 8 * hi) * 2);
        if (!diag) {
#pragma unroll
            for (int d0 = 0; d0 < 2; ++d0)
#pragma unroll
                for (int blk = 0; blk < 2; ++blk) {
                    s0[blk] = __builtin_amdgcn_mfma_f32_32x32x16_bf16(kf[blk][d0], qf[d0], d0 == 0 ? pat : s0[blk], 0, 0, 0);
                    s1[blk] = __builtin_amdgcn_mfma_f32_32x32x16_bf16(kf[blk][2 + d0], qf[2 + d0], d0 == 0 ? pat : s1[blk], 0, 0, 0);
                }
        } else {
            const f32x16 zero16 = {0.f, 0.f, 0.f, 0.f, 0.f, 0.f, 0.f, 0.f, 0.f, 0.f, 0.f, 0.f, 0.f, 0.f, 0.f, 0.f};
#pragma unroll
            for (int d0 = 0; d0 < 2; ++d0)
#pragma unroll
                for (int blk = 0; blk < 2; ++blk) {
                    s0[blk] = __builtin_amdgcn_mfma_f32_32x32x16_bf16(kf[blk][d0], qf[d0], d0 == 0 ? zero16 : s0[blk], 0, 0, 0);
                    s1[blk] = __builtin_amdgcn_mfma_f32_32x32x16_bf16(kf[blk][2 + d0], qf[2 + d0], d0 == 0 ? zero16 : s1[blk], 0, 0, 0);
                }
        }
    }
    bf16x8 pf0[2][2], pf1[2][2];
    attn_d_post(s0, m0, l0, o0, pf0, diag, adj, adj32, dq, slope2, first);
    float dq1 = dq; asm volatile("" : "+v"(dq1));
    attn_d_post(s1, m1, l1, o1, pf1, diag, adj, adj32, dq1, slope2, first);
#pragma unroll
    for (int blk = 0; blk < 2; ++blk) {
        bf16x8 vf[2][2];
#pragma unroll
        for (int kk = 0; kk < 2; ++kk)
#pragma unroll
            for (int d = 0; d < 2; ++d) vf[kk][d] = *(const LAS bf16x8*)(vbuf + ((32 * d + r32) * AT_VLD + 32 * blk + 16 * kk + 8 * hi) * 2);
#pragma unroll
        for (int kk = 0; kk < 2; ++kk)
#pragma unroll
            for (int d = 0; d < 2; ++d) {
                o0[d] = __builtin_amdgcn_mfma_f32_32x32x16_bf16(vf[kk][d], pf0[blk][kk], o0[d], 0, 0, 0);
                o1[d] = __builtin_amdgcn_mfma_f32_32x32x16_bf16(vf[kk][d], pf1[blk][kk], o1[d], 0, 0, 0);
            }
    }
}

DI void attn_d2_x(const bf16x8* qf, const LAS unsigned char* kb, f32x16 (&s1)[2], bf16x8 (&pf0)[2][2], float& m0, float& l0, f32x16 (&o0)[2],
                  const f32x16& pat, const bool diag, const float adj, const float adj32, float dq, float slope2, int r32, int hi, const bool first) {
    f32x16 s0[2];
    {
        bf16x8 kf[2][4];
#pragma unroll
        for (int d0 = 0; d0 < 4; ++d0)
#pragma unroll
            for (int blk = 0; blk < 2; ++blk) kf[blk][d0] = *(const LAS bf16x8*)(kb + ((32 * blk + r32) * AT_KLD + 16 * d0 + 8 * hi) * 2);
        if (!diag) {
#pragma unroll
            for (int d0 = 0; d0 < 2; ++d0)
#pragma unroll
                for (int blk = 0; blk < 2; ++blk) {
                    s0[blk] = __builtin_amdgcn_mfma_f32_32x32x16_bf16(kf[blk][d0], qf[d0], d0 == 0 ? pat : s0[blk], 0, 0, 0);
                    s1[blk] = __builtin_amdgcn_mfma_f32_32x32x16_bf16(kf[blk][2 + d0], qf[2 + d0], d0 == 0 ? pat : s1[blk], 0, 0, 0);
                }
        } else {
            const f32x16 zero16 = {0.f, 0.f, 0.f, 0.f, 0.f, 0.f, 0.f, 0.f, 0.f, 0.f, 0.f, 0.f, 0.f, 0.f, 0.f, 0.f};
#pragma unroll
            for (int d0 = 0; d0 < 2; ++d0)
#pragma unroll
                for (int blk = 0; blk < 2; ++blk) {
                    s0[blk] = __builtin_amdgcn_mfma_f32_32x32x16_bf16(kf[blk][d0], qf[d0], d0 == 0 ? zero16 : s0[blk], 0, 0, 0);
                    s1[blk] = __builtin_amdgcn_mfma_f32_32x32x16_bf16(kf[blk][2 + d0], qf[2 + d0], d0 == 0 ? zero16 : s1[blk], 0, 0, 0);
                }
        }
    }
    attn_d_post(s0, m0, l0, o0, pf0, diag, adj, adj32, dq, slope2, first);
}
DI void attn_d2_y(const LAS unsigned char* vbuf, f32x16 (&s1)[2], const bf16x8 (&pf0)[2][2], float& m1, float& l1, f32x16 (&o1)[2], f32x16 (&o0)[2],
                  const bool diag, const float adj, const float adj32, float dq, float slope2, int r32, int hi, const bool first) {
    bf16x8 pf1[2][2];
    attn_d_post(s1, m1, l1, o1, pf1, diag, adj, adj32, dq, slope2, first);
#pragma unroll
    for (int blk = 0; blk < 2; ++blk) {
        bf16x8 vf[2][2];
#pragma unroll
        for (int kk = 0; kk < 2; ++kk)
#pragma unroll
            for (int d = 0; d < 2; ++d) vf[kk][d] = *(const LAS bf16x8*)(vbuf + ((32 * d + r32) * AT_VLD + 32 * blk + 16 * kk + 8 * hi) * 2);
#pragma unroll
        for (int kk = 0; kk < 2; ++kk)
#pragma unroll
            for (int d = 0; d < 2; ++d) {
                o0[d] = __builtin_amdgcn_mfma_f32_32x32x16_bf16(vf[kk][d], pf0[blk][kk], o0[d], 0, 0, 0);
                o1[d] = __builtin_amdgcn_mfma_f32_32x32x16_bf16(vf[kk][d], pf1[blk][kk], o1[d], 0, 0, 0);
            }
    }
}

template <int MODE>
DI void attn_unit(const AttnArgs& a, unsigned char* smem_, int tid) {
    LAS unsigned char* smem = (LAS unsigned char*)smem_;
    constexpr int NQF = (MODE == 1) ? 6 : 4;
    constexpr bool DIST2 = false;
    const int lane = tid & 63, w = __builtin_amdgcn_readfirstlane(tid >> 6), r32 = lane & 31, hi = lane >> 5;
    constexpr bool SPLIT = (MODE == 3);
    const int grp = w >> 2;
    const int qw = a.q0 + 32 * w;
    const long qrow = a.row0 + qw + r32;
    bf16x8 qf[NQF];
#pragma unroll
    for (int d0 = 0; d0 < NQF; ++d0) qf[d0] = *(const GAS bf16x8*)(gptr(a.Q) + qrow * a.ldq + 16 * d0 + 8 * hi);
    int tb = 0, te = a.S / 64;
    if (MODE == 0) { const int lo = a.q0 - 128, hi_ = a.q0 + 384; tb = (lo < 0 ? 0 : lo) / 64; te = (hi_ > a.S ? a.S : hi_) / 64; }
    const int kkey = tid >> 3, kch = tid & 7;
    const GAS bf16_t* kp = gptr(a.K) + (a.row0 + kkey) * (long)a.ldk + kch * 8;
    const GAS bf16_t* k2p = gptr(a.K2) + (a.row0 + (tid >> 2)) * (long)a.ldk2 + (tid & 3) * 8;
    const GAS bf16_t* vp = gptr(a.VT) + (long)(tid >> 3) * MTOK + a.row0 + (tid & 7) * 8;
    const int kdst = (kkey * AT_KLD + kch * 8) * 2, k2dst = ((tid >> 2) * AT_KLD + 64 + (tid & 3) * 8) * 2, vdst = ((tid >> 3) * AT_VLD + 16 * ((tid & 7) >> 1) + 4 * (tid & 1)) * 2;
    u32x4 kr, k2r, vr;
    kr = *(const GAS u32x4*)(kp + (long)tb * 64 * a.ldk);
    if (MODE == 1 && tid < 256) k2r = *(const GAS u32x4*)(k2p + (long)tb * 64 * a.ldk2);
    vr = *(const GAS u32x4*)(vp + tb * 64);
    *(LAS u32x4*)(smem + kdst) = kr;
    if (MODE == 1 && tid < 256) *(LAS u32x4*)(smem + k2dst) = k2r;
    *(LAS u32x2*)(smem + AT_VOFF + vdst) = (u32x2){vr.x, vr.y}; *(LAS u32x2*)(smem + AT_VOFF + vdst + 16) = (u32x2){vr.z, vr.w};
    if (DIST2 && tb + 1 < te) {
        kr = *(const GAS u32x4*)(kp + (long)(tb + 1) * 64 * a.ldk);
        if (MODE == 1 && tid < 256) k2r = *(const GAS u32x4*)(k2p + (long)(tb + 1) * 64 * a.ldk2);
        vr = *(const GAS u32x4*)(vp + (tb + 1) * 64);
    }
    __syncthreads();
    float m0 = 0.f, l0 = 0.f, m1 = 0.f, l1 = 0.f;
    if (MODE == 0) { m0 = a.sink2; l0 = hi == 0 ? 1.f : 0.f; }
    f32x16 o0[2], o1[2], ng0, ng1, pat;
#pragma unroll
    for (int r = 0; r < 16; ++r) { ng0[r] = -m0; ng1[r] = 0.f; }
    bool flipped = false;
    if (MODE == 3) {
#pragma unroll
        for (int r = 0; r < 16; ++r) pat[r] = a.slope2 * (float)((r & 3) + 8 * (r >> 2));
    }
#pragma unroll
    for (int d = 0; d < 2; ++d)
#pragma unroll
        for (int r = 0; r < 16; ++r) { o0[d][r] = 0.f; o1[d][r] = 0.f; }
    auto step = [&](const int t, u32x4& xk, u32x4& xk2, u32x4& xv, u32x4& yk, u32x4& yk2, u32x4& yv) __attribute__((always_inline)) {
        const int cur = (t - tb) & 1;
        const bool more = (t + 1 < te);
        const bool more2 = (t + 2 < te);
        if (DIST2 ? more2 : more) {
            const int tl = t + (DIST2 ? 2 : 1);
            yk = *(const GAS u32x4*)(kp + (long)tl * 64 * a.ldk);
            if (MODE == 1 && tid < 256) yk2 = *(const GAS u32x4*)(k2p + (long)tl * 64 * a.ldk2);
            yv = *(const GAS u32x4*)(vp + tl * 64);
        }
        const LAS unsigned char* kb = smem + cur * AT_KBUF;
        const LAS unsigned char* vb = smem + AT_VOFF + cur * AT_VBUF;
        const int k0 = t * 64;
        bool active = true;
        if (MODE == 0) active = (k0 + 63 >= qw - 128) && (k0 <= qw + 31 + 128);
        if (SPLIT && MODE == 3) {
            f32x16 s1d[2]; bf16x8 pf0d[2][2];
            const float dq = (float)(qw + r32 - k0 - 4 * hi);
            const bool first = (t == tb);
            const bool right = (k0 > qw + 31), diag = !right && !(k0 + 63 < qw);
            if (right && !flipped) {
#pragma unroll
                for (int r = 0; r < 16; ++r) { pat[r] = -pat[r]; asm volatile("" : "+v"(pat[r])); }
                flipped = true;
            }
            const float adj = right ? a.slope2 * dq : -a.slope2 * dq;
            const float adj32 = right ? -32.f * a.slope2 : 32.f * a.slope2;
            attn_d2_x(qf, kb, s1d, pf0d, m0, l0, o0, pat, diag, adj, adj32, dq, a.slope2, r32, hi, first);
            if (grp == 1 && more) {
                LAS unsigned char* nb = smem + (cur ^ 1) * AT_KBUF;
                *(LAS u32x4*)(nb + kdst) = xk;
                *(LAS u32x2*)(smem + AT_VOFF + (cur ^ 1) * AT_VBUF + vdst) = (u32x2){xv.x, xv.y}; *(LAS u32x2*)(smem + AT_VOFF + (cur ^ 1) * AT_VBUF + vdst + 16) = (u32x2){xv.z, xv.w};
            }
            asm volatile("s_waitcnt lgkmcnt(0)" ::: "memory"); __builtin_amdgcn_s_barrier(); asm volatile("" ::: "memory");
            float dq1 = dq; asm volatile("" : "+v"(dq1));
            attn_d2_y(vb, s1d, pf0d, m1, l1, o1, o0, diag, adj, adj32, dq1, a.slope2, r32, hi, first);
            if (grp == 0 && more) {
                LAS unsigned char* nb = smem + (cur ^ 1) * AT_KBUF;
                *(LAS u32x4*)(nb + kdst) = xk;
                *(LAS u32x2*)(smem + AT_VOFF + (cur ^ 1) * AT_VBUF + vdst) = (u32x2){xv.x, xv.y}; *(LAS u32x2*)(smem + AT_VOFF + (cur ^ 1) * AT_VBUF + vdst + 16) = (u32x2){xv.z, xv.w};
            }
            asm volatile("s_waitcnt lgkmcnt(0)" ::: "memory"); __builtin_amdgcn_s_barrier(); asm volatile("" ::: "memory");
            return;
        }
        if (SPLIT && MODE != 3) {
            f32x16 sp[2];
            if (active) {
                const float dq = (float)(qw + r32 - k0 - 4 * hi);
                const bool first = (MODE != 0) && (t == tb);
                if (MODE == 0) attn_tile_x<4, 0, true, true>(qf, kb, sp, m0, ng0, l0, o0, dq, a.slope2, r32, hi, first);
                else if (MODE == 1) attn_tile_x<6, 0, false, false>(qf, kb, sp, m0, ng0, l0, o0, dq, a.slope2, r32, hi, first);
                else attn_tile_x<4, 0, false, false>(qf, kb, sp, m0, ng0, l0, o0, dq, a.slope2, r32, hi, first);
            }
            if (grp == 1 && more) {
                LAS unsigned char* nb = smem + (cur ^ 1) * AT_KBUF;
                *(LAS u32x4*)(nb + kdst) = xk;
                if (MODE == 1 && tid < 256) *(LAS u32x4*)(nb + k2dst) = xk2;
                *(LAS u32x2*)(smem + AT_VOFF + (cur ^ 1) * AT_VBUF + vdst) = (u32x2){xv.x, xv.y}; *(LAS u32x2*)(smem + AT_VOFF + (cur ^ 1) * AT_VBUF + vdst + 16) = (u32x2){xv.z, xv.w};
            }
            asm volatile("s_waitcnt lgkmcnt(0)" ::: "memory"); __builtin_amdgcn_s_barrier(); asm volatile("" ::: "memory");
            if (active) attn_tile_y(sp, vb, l0, o0, r32, hi);
            if (grp == 0 && more) {
                LAS unsigned char* nb = smem + (cur ^ 1) * AT_KBUF;
                *(LAS u32x4*)(nb + kdst) = xk;
                if (MODE == 1 && tid < 256) *(LAS u32x4*)(nb + k2dst) = xk2;
                *(LAS u32x2*)(smem + AT_VOFF + (cur ^ 1) * AT_VBUF + vdst) = (u32x2){xv.x, xv.y}; *(LAS u32x2*)(smem + AT_VOFF + (cur ^ 1) * AT_VBUF + vdst + 16) = (u32x2){xv.z, xv.w};
            }
            asm volatile("s_waitcnt lgkmcnt(0)" ::: "memory"); __builtin_amdgcn_s_barrier(); asm volatile("" ::: "memory");
            return;
        }
        if (active) {
            const float dq = (float)(qw + r32 - k0 - 4 * hi);
            const bool first = (MODE != 0) && (t == tb);
            if (MODE == 0) attn_tile<4, 0, true, true>(qf, kb, vb, m0, ng0, l0, o0, dq, a.slope2, r32, hi, first);
            else if (MODE == 1) attn_tile<6, 0, false, false>(qf, kb, vb, m0, ng0, l0, o0, dq, a.slope2, r32, hi, first);
            else if (MODE == 2) attn_tile<4, 0, false, false>(qf, kb, vb, m0, ng0, l0, o0, dq, a.slope2, r32, hi, first);
            else {
                const bool right = (k0 > qw + 31), diag = !right && !(k0 + 63 < qw);
                if (right && !flipped) {
#pragma unroll
                    for (int r = 0; r < 16; ++r) { pat[r] = -pat[r]; asm volatile("" : "+v"(pat[r])); }
                    flipped = true;
                }
                const float adj = right ? a.slope2 * dq : -a.slope2 * dq;
                const float adj32 = right ? -32.f * a.slope2 : 32.f * a.slope2;
                attn_tile_d2(qf, kb, vb, m0, l0, o0, m1, l1, o1, pat, diag, adj, adj32, dq, a.slope2, r32, hi, first);
            }
        }
        if (more) {
            LAS unsigned char* nb = smem + (cur ^ 1) * AT_KBUF;
            *(LAS u32x4*)(nb + kdst) = xk;
            if (MODE == 1 && tid < 256) *(LAS u32x4*)(nb + k2dst) = xk2;
            *(LAS u32x2*)(smem + AT_VOFF + (cur ^ 1) * AT_VBUF + vdst) = (u32x2){xv.x, xv.y}; *(LAS u32x2*)(smem + AT_VOFF + (cur ^ 1) * AT_VBUF + vdst + 16) = (u32x2){xv.z, xv.w};
        }
        asm volatile("s_waitcnt lgkmcnt(0)" ::: "memory"); __builtin_amdgcn_s_barrier(); asm volatile("" ::: "memory");
    };
    u32x4 kn, k2n, vn;
    if (SPLIT && grp == 1) { __builtin_amdgcn_s_barrier(); asm volatile("" ::: "memory"); }
    if (DIST2) {
        for (int t = tb; t < te; t += 2) {
            step(t, kr, k2r, vr, kn, k2n, vn);
            if (t + 1 < te) step(t + 1, kn, k2n, vn, kr, k2r, vr);
        }
    } else {
        for (int t = tb; t < te; ++t) step(t, kr, k2r, vr, kr, k2r, vr);
    }
    if (SPLIT && grp == 0) { __builtin_amdgcn_s_barrier(); asm volatile("" ::: "memory"); }
    l0 += __shfl_xor(l0, 32);
    const float i0 = 1.f / l0;
    GAS bf16_t* op = gptr(a.O) + qrow * DMODEL;
    if (MODE != 3) {
#pragma unroll
        for (int d = 0; d < 2; ++d)
#pragma unroll
            for (int g4 = 0; g4 < 4; ++g4) {
                u32x2 wv; wv.x = pk2(o0[d][4 * g4] * i0, o0[d][4 * g4 + 1] * i0); wv.y = pk2(o0[d][4 * g4 + 2] * i0, o0[d][4 * g4 + 3] * i0);
                *(GAS u32x2*)(op + 32 * d + 8 * g4 + 4 * hi) = wv;
            }
    } else {
        l1 += __shfl_xor(l1, 32);
        const float i1 = a.lam / l1;
        float ss = 0.f;
#pragma unroll
        for (int d = 0; d < 2; ++d)
#pragma unroll
            for (int r = 0; r < 16; ++r) { const float v = o0[d][r] * i0 - o1[d][r] * i1; o0[d][r] = v; ss += v * v; }
        ss += __shfl_xor(ss, 32);
        const float rn = rsqrtf(ss * (1.f / 64.f) + EPS) * a.post;
#pragma unroll
        for (int d = 0; d < 2; ++d)
#pragma unroll
            for (int g4 = 0; g4 < 4; ++g4) {
                const int dd = 32 * d + 8 * g4 + 4 * hi;
                const f32x4 gn = *(const GAS f32x4*)(gptr(a.subn) + dd);
                u32x2 wv; wv.x = pk2(o0[d][4 * g4] * rn * gn[0], o0[d][4 * g4 + 1] * rn * gn[1]); wv.y = pk2(o0[d][4 * g4 + 2] * rn * gn[2], o0[d][4 * g4 + 3] * rn * gn[3]);
                *(GAS u32x2*)(op + dd) = wv;
            }
    }
}

DI void attn_pair_sm(f32x16 (&s)[2], float& mhat, float& l, f32x16 (&o)[2], bf16x8 (&pf)[2][2], const bool first) {
    float mx = s[0][0];
#pragma unroll
    for (int r = 1; r < 16; ++r) mx = fmaxf(mx, s[0][r]);
#pragma unroll
    for (int r = 0; r < 16; ++r) mx = fmaxf(mx, s[1][r]);
    mx = fmaxf(mx, __shfl_xor(mx, 32)) - mhat;
    if (first || __any(mx > 8.f)) {
        const float dl = first ? mx : fmaxf(mx, 0.f);
        mhat += dl;
        const float f = first ? 1.f : __builtin_amdgcn_exp2f(-dl);
        l *= f;
#pragma unroll
        for (int d = 0; d < 2; ++d)
#pragma unroll
            for (int r = 0; r < 16; ++r) o[d][r] *= f;
    }
    float ps = 0.f;
#pragma unroll
    for (int blk = 0; blk < 2; ++blk)
#pragma unroll
        for (int r = 0; r < 16; ++r) { const float p = __builtin_amdgcn_exp2f(s[blk][r] - mhat); s[blk][r] = p; ps += p; }
    l += ps;
#pragma unroll
    for (int blk = 0; blk < 2; ++blk)
#pragma unroll
        for (int kk = 0; kk < 2; ++kk) {
            u32x4 pw; pw.x = pk2(s[blk][8 * kk + 0], s[blk][8 * kk + 1]); pw.y = pk2(s[blk][8 * kk + 2], s[blk][8 * kk + 3]);
            pw.z = pk2(s[blk][8 * kk + 4], s[blk][8 * kk + 5]); pw.w = pk2(s[blk][8 * kk + 6], s[blk][8 * kk + 7]);
            pf[blk][kk] = __builtin_bit_cast(bf16x8, pw);
        }
}
DI void attn_unit_pairC(const AttnArgs& a, unsigned char* smem_, int tid) {
    LAS unsigned char* smem = (LAS unsigned char*)smem_;
    const int lane = tid & 63, w = __builtin_amdgcn_readfirstlane(tid >> 6), r32 = lane & 31, hi = lane >> 5;
    const int qw = a.q0 + 32 * w;
    const long qrow = a.row0 + qw + r32;
    bf16x8 qfA[4], qfB[4];
#pragma unroll
    for (int d0 = 0; d0 < 4; ++d0) { qfA[d0] = *(const GAS bf16x8*)(gptr(a.Q) + qrow * a.ldq + 16 * d0 + 8 * hi); qfB[d0] = *(const GAS bf16x8*)(gptr(a.Q) + qrow * a.ldq + 64 + 16 * d0 + 8 * hi); }
    const int tb = 0, te = a.S / 64;
    const int kkey = tid >> 3, kch = tid & 7;
    const GAS bf16_t* kp = gptr(a.K) + (a.row0 + kkey) * (long)a.ldk + kch * 8;
    const GAS bf16_t* vp = gptr(a.VT) + (long)(tid >> 3) * MTOK + a.row0 + (tid & 7) * 8;
    const int kdst = (kkey * AT_KLD + kch * 8) * 2, vdst = ((tid >> 3) * AT_VLD + 16 * ((tid & 7) >> 1) + 4 * (tid & 1)) * 2;
    u32x4 kr, vr;
    kr = *(const GAS u32x4*)(kp + (long)tb * 64 * a.ldk);
    vr = *(const GAS u32x4*)(vp + tb * 64);
    *(LAS u32x4*)(smem + kdst) = kr;
    *(LAS u32x2*)(smem + AT_VOFF + vdst) = (u32x2){vr.x, vr.y}; *(LAS u32x2*)(smem + AT_VOFF + vdst + 16) = (u32x2){vr.z, vr.w};
    __syncthreads();
    float mA = 0.f, lA = 0.f, mB = 0.f, lB = 0.f;
    f32x16 oA[2], oB[2];
#pragma unroll
    for (int d = 0; d < 2; ++d)
#pragma unroll
        for (int r = 0; r < 16; ++r) { oA[d][r] = 0.f; oB[d][r] = 0.f; }
    const f32x16 zero16 = {0.f, 0.f, 0.f, 0.f, 0.f, 0.f, 0.f, 0.f, 0.f, 0.f, 0.f, 0.f, 0.f, 0.f, 0.f, 0.f};
    for (int t = tb; t < te; ++t) {
        const int cur = (t - tb) & 1;
        const bool more = (t + 1 < te);
        if (more) { kr = *(const GAS u32x4*)(kp + (long)(t + 1) * 64 * a.ldk); vr = *(const GAS u32x4*)(vp + (t + 1) * 64); }
        const LAS unsigned char* kb = smem + cur * AT_KBUF;
        const LAS unsigned char* vb = smem + AT_VOFF + cur * AT_VBUF;
        const bool first = (t == tb);
        f32x16 sA[2], sB[2];
        {
            bf16x8 kf[2][4];
#pragma unroll
            for (int d0 = 0; d0 < 4; ++d0)
#pragma unroll
                for (int blk = 0; blk < 2; ++blk) kf[blk][d0] = *(const LAS bf16x8*)(kb + ((32 * blk + r32) * AT_KLD + 16 * d0 + 8 * hi) * 2);
#pragma unroll
            for (int d0 = 0; d0 < 4; ++d0)
#pragma unroll
                for (int blk = 0; blk < 2; ++blk) {
                    sA[blk] = __builtin_amdgcn_mfma_f32_32x32x16_bf16(kf[blk][d0], qfA[d0], d0 == 0 ? zero16 : sA[blk], 0, 0, 0);
                    sB[blk] = __builtin_amdgcn_mfma_f32_32x32x16_bf16(kf[blk][d0], qfB[d0], d0 == 0 ? zero16 : sB[blk], 0, 0, 0);
                }
        }
        bf16x8 pfA[2][2], pfB[2][2];
        attn_pair_sm(sA, mA, lA, oA, pfA, first);
        attn_pair_sm(sB, mB, lB, oB, pfB, first);
#pragma unroll
        for (int blk = 0; blk < 2; ++blk) {
            bf16x8 vf[2][2];
#pragma unroll
            for (int kk = 0; kk < 2; ++kk)
#pragma unroll
                for (int d = 0; d < 2; ++d) vf[kk][d] = *(const LAS bf16x8*)(vb + ((32 * d + r32) * AT_VLD + 32 * blk + 16 * kk + 8 * hi) * 2);
#pragma unroll
            for (int kk = 0; kk < 2; ++kk)
#pragma unroll
                for (int d = 0; d < 2; ++d) {
                    oA[d] = __builtin_amdgcn_mfma_f32_32x32x16_bf16(vf[kk][d], pfA[blk][kk], oA[d], 0, 0, 0);
                    oB[d] = __builtin_amdgcn_mfma_f32_32x32x16_bf16(vf[kk][d], pfB[blk][kk], oB[d], 0, 0, 0);
                }
        }
        if (more) {
            LAS unsigned char* nb = smem + (cur ^ 1) * AT_KBUF;
            *(LAS u32x4*)(nb + kdst) = kr;
            *(LAS u32x2*)(smem + AT_VOFF + (cur ^ 1) * AT_VBUF + vdst) = (u32x2){vr.x, vr.y}; *(LAS u32x2*)(smem + AT_VOFF + (cur ^ 1) * AT_VBUF + vdst + 16) = (u32x2){vr.z, vr.w};
        }
        asm volatile("s_waitcnt lgkmcnt(0)" ::: "memory"); __builtin_amdgcn_s_barrier(); asm volatile("" ::: "memory");
    }
    lA += __shfl_xor(lA, 32); lB += __shfl_xor(lB, 32);
    const float iA = 1.f / lA, iB = 1.f / lB;
    GAS bf16_t* op = gptr(a.O) + qrow * DMODEL;
#pragma unroll
    for (int d = 0; d < 2; ++d)
#pragma unroll
        for (int g4 = 0; g4 < 4; ++g4) {
            u32x2 wa, wb;
            wa.x = pk2(oA[d][4 * g4] * iA, oA[d][4 * g4 + 1] * iA); wa.y = pk2(oA[d][4 * g4 + 2] * iA, oA[d][4 * g4 + 3] * iA);
            wb.x = pk2(oB[d][4 * g4] * iB, oB[d][4 * g4 + 1] * iB); wb.y = pk2(oB[d][4 * g4 + 2] * iB, oB[d][4 * g4 + 3] * iB);
            *(GAS u32x2*)(op + 32 * d + 8 * g4 + 4 * hi) = wa;
            *(GAS u32x2*)(op + 64 + 32 * d + 8 * g4 + 4 * hi) = wb;
        }
}

template <class ColMap, class Scale>
DI void wprep(const float* __restrict__ src, int ldsrc, int K, bf16_t* dst, int ndst, const float* __restrict__ gain, ColMap cm, Scale sc, LAS float* scr, int gw, int ngw, int lane, int& ibase) {
    const int nblk = ndst / 32, nitems = (K / 64) * nblk;
    const int first = (gw + ngw - (ibase % ngw)) % ngw;
    ibase += nitems;
    for (int it = first; it < nitems; it += ngw) {
        const int kb = it / nblk, nb = it - kb * nblk, k0 = 64 * kb, n0 = 32 * nb;
        const int c = cm(n0 + (lane & 31)); const float sv = sc(n0 + (lane & 31));
        float wv[32];
#pragma unroll
        for (int i = 0; i < 32; ++i) { const int k = k0 + 2 * i + (lane >> 5); wv[i] = c >= 0 ? src[(long)k * ldsrc + c] : 0.f; }
#pragma unroll
        for (int i = 0; i < 32; ++i) {
            const int kk = 2 * i + (lane >> 5), k = k0 + kk;
            scr[kk * 33 + (lane & 31)] = wv[i] * (gain ? gain[k] : 1.f) * sv;
        }
        const int c8 = lane & 7;
#pragma unroll
        for (int j = 0; j < 4; ++j) {
            const int n = (lane >> 3) + 8 * j; const LAS float* q = scr + (8 * c8) * 33 + n;
            u32x4 o; o.x = pk2(q[0], q[33]); o.y = pk2(q[2 * 33], q[3 * 33]); o.z = pk2(q[4 * 33], q[5 * 33]); o.w = pk2(q[6 * 33], q[7 * 33]);
            *(u32x4*)(dst + (long)(n0 + n) * K + k0 + 8 * c8) = o;
        }
        asm volatile("s_waitcnt lgkmcnt(0)" ::: "memory");
    }
}

DI int in_colmap(int n) {
    if (n < 256) return n;
    if (n < 384) return 256 + (n - 256);
    if (n < 512) return 1184 + (n - 384);
    if (n < 768) return 512 + (n - 512);
    if (n < 896) return 768 + (n - 768);
    if (n < 928) return 896 + (n - 896);
    if (n < 1024) return -1;
    if (n < 1280) return 928 + (n - 1024);
    if (n < 1536) return 1440 + (n - 1280);
    if (n < 1792) return 1696 + (n - 1536);
    if (n < 1920) return 384 + (n - 1792);
    if (n < 2048) return 1312 + (n - 1920);
    return 1952 + (n - 2048);
}

DI const float* inptr(const Params& p, int i) { asm volatile("" : "+s"(i)); return p.in[i]; }
#define XB_TMO      128
#define XB_XCNT(j)  (256  + 64 * (j))
#define XB_XSUB(j)  (1280 + 64 * (j))
#define XB_XGEN(j)  (2304 + 64 * (j))
#define XB_TOP      3328
#define XB_TOPGEN   3392
#define XCD_BAR_WORDS 3456
#define XB_SPIN_CAP (1u << 18)

__device__ __forceinline__ unsigned xb_ld(unsigned* p)              { return __hip_atomic_load(p, __ATOMIC_RELAXED, __HIP_MEMORY_SCOPE_AGENT); }
__device__ __forceinline__ unsigned xb_add(unsigned* p, unsigned v) { return __hip_atomic_fetch_add(p, v, __ATOMIC_RELAXED, __HIP_MEMORY_SCOPE_AGENT); }
__device__ __forceinline__ unsigned xb_xcc_id() { return (unsigned)__builtin_amdgcn_s_getreg((3 << 11) | 20) & 0xFu; }
#define XB_SPIN(cond, bar) do { unsigned _sp = 0; while (cond) { __builtin_amdgcn_s_sleep(1); \
    if ((++_sp & 255u) == 0u) { if (xb_ld(&(bar)[XB_TMO])) break; if (_sp > XB_SPIN_CAP) { atomicAdd(&(bar)[XB_TMO], 1u); break; } } } } while (0)

struct XcdBarrier {
    unsigned* bar; unsigned x;
    volatile LAS unsigned* st;
};

__device__ __forceinline__ XcdBarrier xcd_barrier_post(unsigned* bar, volatile LAS unsigned* st, int wid) {
    XcdBarrier b; b.bar = bar; b.x = xb_xcc_id(); b.st = st;
    if (wid == 0 && lane_id() == 0) (void)xb_add(&bar[XB_XCNT(b.x)], 1u);
    return b;
}
__device__ __forceinline__ void xcd_barrier_complete(unsigned* bar, unsigned x, unsigned& nloc, unsigned& nx) {
    const unsigned G = gridDim.x * gridDim.y * gridDim.z;
    unsigned sum, cnt, mine, sp = 0u;
    for (;;) {
        sum = 0u; cnt = 0u; mine = 0u;
#pragma unroll
        for (unsigned j = 0; j < 16; ++j) { const unsigned c = xb_ld(&bar[XB_XCNT(j)]); sum += c; cnt += (c > 0u) ? 1u : 0u; mine = (j == x) ? c : mine; }
        if (sum == G) break;
        __builtin_amdgcn_s_sleep(1);
        if ((++sp & 255u) == 0u) { if (xb_ld(&bar[XB_TMO])) break; if (sp > XB_SPIN_CAP) { atomicAdd(&bar[XB_TMO], 1u); break; } }
    }
    nloc = mine > 0u ? mine : 1u; nx = cnt > 0u ? cnt : 1u;
}

__device__ __forceinline__ void xcd_barrier(const XcdBarrier& b, int wid) {
    asm volatile("s_waitcnt vmcnt(0)" ::: "memory");
    __syncthreads();
    if (wid == 0 && lane_id() == 0) {
        unsigned* bar = b.bar;
        __builtin_amdgcn_s_waitcnt(0);
        unsigned nloc = b.st[0], nx = b.st[1];
        if (nloc == 0u) { xcd_barrier_complete(bar, b.x, nloc, nx); b.st[0] = nloc; b.st[1] = nx; }
        const unsigned old = xb_add(&bar[XB_XSUB(b.x)], 1u);
        const unsigned gen = old / nloc;
        if (old + 1u == (gen + 1u) * nloc) {
            __builtin_amdgcn_fence(__ATOMIC_RELEASE, "agent");
            asm volatile("s_waitcnt vmcnt(0)" ::: "memory");
            const unsigned og = xb_add(&bar[XB_TOP], 1u);
            const unsigned tg = og / nx;
            if (og + 1u == (tg + 1u) * nx) xb_add(&bar[XB_TOPGEN], 1u);
            else XB_SPIN(xb_ld(&bar[XB_TOPGEN]) == tg, bar);
            __builtin_amdgcn_fence(__ATOMIC_ACQUIRE, "agent");
            xb_add(&bar[XB_XGEN(b.x)], 1u);
            asm volatile("s_waitcnt vmcnt(0)" ::: "memory");
        } else {
            XB_SPIN(xb_ld(&bar[XB_XGEN(b.x)]) == gen, bar);
            __builtin_amdgcn_fence(__ATOMIC_ACQUIRE, "agent");
            asm volatile("s_waitcnt vmcnt(0)" ::: "memory");
        }
    }
    __syncthreads();
}
DI void grid_barrier(unsigned* ctr, unsigned target, int wid) {
    __threadfence();
    __syncthreads();
    if (wid == 0 && lane_id() == 0) {
        __hip_atomic_fetch_add(ctr, 1u, __ATOMIC_RELEASE, __HIP_MEMORY_SCOPE_AGENT);
        unsigned spins = 0;
        while (__hip_atomic_load(ctr, __ATOMIC_ACQUIRE, __HIP_MEMORY_SCOPE_AGENT) < target) { __builtin_amdgcn_s_sleep(4); if (++spins > (1u << 24)) break; }
    }
    __syncthreads();
    __threadfence();
}

template <int PH>
DI void run_phase(const Params& p, const int wid, unsigned char* smem) {
    constexpr int ph = PH;
    const int wr = wid >> 2, wc = wid & 3;
    const int nblk = gridDim.x, bid = blockIdx.x;
    const long gthreads = (long)nblk * NTHREADS;
    const int gw = bid * 8 + wid, ngw = nblk * 8;
        const int lane = lane_id(), tid = wid * 64 + lane;
        unsigned char* ws = p.ws; asm volatile("" : "+s"(ws));
            float* pout = p.out; asm volatile("" : "+s"(pout));
        unsigned* ctl = (unsigned*)(ws + WS_CTL);
        float* stat = (float*)(ws + WS_STAT);
        float* rope = (float*)(ws + WS_ROPE);
        bf16_t* H = (bf16_t*)(ws + WS_H); bf16_t* VT = (bf16_t*)(ws + WS_VT); bf16_t* Gb = (bf16_t*)(ws + WS_G);
        bf16_t* XB = (bf16_t*)(ws + WS_XB); bf16_t* QB = (bf16_t*)(ws + WS_QB); bf16_t* KBN = (bf16_t*)(ws + WS_KBN); bf16_t* ATT = (bf16_t*)(ws + WS_ATT);
        const long gtid = (long)bid * NTHREADS + tid;
        if (ph == 0 && (SUBMASK & 0x100)) {
            for (long i = gtid; i < 5L * MTOK; i += gthreads) stat[MTOK + i] = 0.f;
            for (long i = gtid; i < 4096L * 16; i += gthreads) {
                const int pos = (int)(i >> 4), k = (int)(i & 15);
                const float inv = exp2f(-(float)k * (13.287712379549449f / 16.f));
                float sn, cs; sincosf((float)pos * inv, &sn, &cs);
                rope[2 * i] = cs; rope[2 * i + 1] = sn;
            }
            {
                const float* xin0 = inptr(p, 0); const float* xin1 = inptr(p, 1);
                for (int row0 = gw; row0 < MTOK; row0 += 4 * ngw) {
                    f32x4 va[4][4];
#pragma unroll
                    for (int q = 0; q < 4; ++q) {
                        const int row = row0 + q * ngw;
                        if (row < MTOK) {
                            const GAS float* xr = row < MPROMPT ? gptr(xin0) + (long)row * DMODEL : gptr(xin1) + (long)(row - MPROMPT) * DMODEL;
#pragma unroll
                            for (int j = 0; j < 2; ++j) { va[q][2 * j] = *(const GAS f32x4*)(xr + 512 * j + 8 * lane); va[q][2 * j + 1] = *(const GAS f32x4*)(xr + 512 * j + 8 * lane + 4); }
                        }
                    }
#pragma unroll
                    for (int q = 0; q < 4; ++q) {
                        const int row = row0 + q * ngw;
                        if (row < MTOK) {
                            float ss = 0.f;
#pragma unroll
                            for (int j = 0; j < 2; ++j) {
                                const f32x4 a = va[q][2 * j], b = va[q][2 * j + 1];
                                ss += (a[0] * a[0] + a[1] * a[1]) + (a[2] * a[2] + a[3] * a[3]) + (b[0] * b[0] + b[1] * b[1]) + (b[2] * b[2] + b[3] * b[3]);
                                u32x4 w; w.x = pk2(a[0], a[1]); w.y = pk2(a[2], a[3]); w.z = pk2(b[0], b[1]); w.w = pk2(b[2], b[3]);
                                *(GAS u32x4*)(gptr(XB) + (long)row * DMODEL + 512 * j + 8 * lane) = w;
                            }
#pragma unroll
                            for (int o = 1; o < 64; o <<= 1) ss += __shfl_xor(ss, o);
                            if (lane == 0) stat[ST_ATTN0 * MTOK + row] = ss;
                        }
                    }
                }
            }
            LAS float* scr = (LAS float*)((LAS unsigned char*)smem + wid * 8448);
            int ibase = 0;
            for (int l = 0; l < 2; ++l) {
                unsigned char* wl = ws + WS_W + l * WL_STRIDE;
                wprep(inptr(p, 3) + (long)l * DMODEL * INW, INW, DMODEL, (bf16_t*)(wl + WL_IN), 2304, inptr(p, 2) + l * DMODEL, [](int n) { return in_colmap(n); },
                      [](int n) { return n < 256 ? 0.125f * LOG2E : ((n >= 1280 && n < 1536) ? 0.17677669529663687f * LOG2E : 1.f); }, scr, gw, ngw, lane, ibase);
                wprep(inptr(p, 6) + (long)l * 256 * 384, 384, 256, (bf16_t*)(wl + WL_QUP), 512, inptr(p, 5) + l * 256,
                      [](int s) { if (s >= 384) return -1; const int h = s / 96, w = s % 96; if (w < 64) return h * 96 + w; const int g = (w - 64) >> 3, e = (w - 64) & 7; return h * 96 + 64 + (e < 4 ? 4 * g + e : 16 + 4 * g + (e - 4)); },
                      [](int) { return 0.10206207261596575f * LOG2E; }, scr, gw, ngw, lane, ibase);
                wprep(inptr(p, 8) + (long)l * 128 * 512, 512, 128, (bf16_t*)(wl + WL_KUP), 256, inptr(p, 7) + l * 128, [](int n) { return (n >> 6) * 128 + (n & 63); }, [](int) { return 1.f; }, scr, gw, ngw, lane, ibase);
                wprep(inptr(p, 8) + (long)l * 128 * 512, 512, 128, (bf16_t*)(wl + WL_VUP), 256, inptr(p, 7) + l * 128, [](int n) { return (n >> 6) * 128 + 64 + (n & 63); }, [](int) { return 1.f; }, scr, gw, ngw, lane, ibase);
                wprep(inptr(p, 16) + (long)l * DMODEL * DMODEL, DMODEL, DMODEL, (bf16_t*)(wl + WL_OUT), 1024, nullptr, [](int n) { return n; }, [](int) { return 1.f; }, scr, gw, ngw, lane, ibase);
                wprep(inptr(p, 18) + (long)l * DMODEL * DFF2, DFF2, DMODEL, (bf16_t*)(wl + WL_UP), DFF2, inptr(p, 17) + l * DMODEL,
                      [](int n) { const int pn = n >> 8, r = n & 255; return (r >> 7) * DFF + 128 * pn + (r & 127); }, [](int) { return 1.f; }, scr, gw, ngw, lane, ibase);
                wprep(inptr(p, 22) + (long)l * DFF * DMODEL, DMODEL, DFF, (bf16_t*)(wl + WL_DOWN), 1024, nullptr, [](int n) { return n; }, [](int) { return 1.f; }, scr, gw, ngw, lane, ibase);
            }
            for (long i = gtid; i < 2L * DFF; i += gthreads) {
                const int l = (int)(i / DFF), ff = (int)(i % DFF);
                const float* cw = inptr(p, 20) + (long)l * 3 * DFF2; const float* cb = inptr(p, 21) + (long)l * DFF2;
                float* o = (float*)(ws + WS_CP) + i * 8;
                o[0] = cw[ff]; o[1] = cw[DFF2 + ff]; o[2] = cw[2 * DFF2 + ff]; o[3] = cb[ff];
                o[4] = cw[DFF + ff]; o[5] = cw[DFF2 + DFF + ff]; o[6] = cw[2 * DFF2 + DFF + ff]; o[7] = cb[DFF + ff];
            }
            if (gtid < 2) {
                const int l = (int)gtid;
                float s1 = 0.f, s2 = 0.f;
                for (int i = 0; i < 32; ++i) { s1 += inptr(p, 11)[l * 32 + i] * inptr(p, 12)[l * 32 + i]; s2 += inptr(p, 13)[l * 32 + i] * inptr(p, 14)[l * 32 + i]; }
                const float lam_init = 0.8f - 0.6f * expf(-0.3f * (float)l);
                ((float*)ctl)[CW_LAM + l] = expf(s1) - expf(s2) + lam_init;
            }
        } else if (ph == NPHASES - 1 && (SUBMASK & 0x200)) {
            const float* gf = inptr(p, 23);
            f32x4 gv[4];
#pragma unroll
            for (int j = 0; j < 4; ++j) gv[j] = *(const f32x4*)(gf + 256 * j + 4 * lane);
            for (int row0 = gw; row0 < MTOK; row0 += 4 * ngw) {
                f32x4 v[4][4];
#pragma unroll
                for (int q = 0; q < 4; ++q) {
                    const int row = row0 + q * ngw;
                    if (row < MTOK) {
#pragma unroll
                        for (int j = 0; j < 4; ++j) v[q][j] = *(const GAS f32x4*)(gptr(pout) + (long)row * DMODEL + 256 * j + 4 * lane);
                    }
                }
#pragma unroll
                for (int q = 0; q < 4; ++q) {
                    const int row = row0 + q * ngw;
                    if (row < MTOK) {
                        float ss = 0.f;
#pragma unroll
                        for (int j = 0; j < 4; ++j) ss += (v[q][j][0] * v[q][j][0] + v[q][j][1] * v[q][j][1]) + (v[q][j][2] * v[q][j][2] + v[q][j][3] * v[q][j][3]);
#pragma unroll
                        for (int o = 1; o < 64; o <<= 1) ss += __shfl_xor(ss, o);
                        const float rs = rsqrtf(ss * (1.f / 1024.f) + EPS);
#pragma unroll
                        for (int j = 0; j < 4; ++j) *(GAS f32x4*)(gptr(pout) + (long)row * DMODEL + 256 * j + 4 * lane) = v[q][j] * rs * gv[j];
                    }
                }
            }
        } else {
            const int l = (ph - 1) / 7, sub = (ph - 1) % 7;
            unsigned char* wl = ws + WS_W + l * WL_STRIDE;
            const float* rs_attn = stat + (l == 0 ? ST_ATTN0 : ST_ATTN1) * MTOK;
            float* rs_ffn = stat + (l == 0 ? ST_FFN0 : ST_FFN1) * MTOK;
            float* sqq = stat + ST_SQQ * MTOK; float* sqkv = stat + ST_SQKV * MTOK;
            PG8_LAS unsigned char* lds3 = (PG8_LAS unsigned char*)smem;
            if (sub == 0 && (SUBMASK & 1)) {
                SchedInproj S; S.o.init(192, 9); S.XB = (const char*)XB; S.W = (const char*)(wl + WL_IN);
                EpiInproj E{EpiScaleStore<0>{H, HW, rs_attn, 1.f / 1024.f, HW, sqq, sqkv}, EpiScaleStore<1>{VT, MTOK, rs_attn, 1.f / 1024.f, MTOK, nullptr, nullptr}};
                pg8::gemm_phase<false>(lds3, wid, DMODEL, DMODEL, DMODEL, S, E); if (PROBE_GEMM > 1) pg8::gemm_phase<false>(lds3, wid, DMODEL, DMODEL, DMODEL, S, E);
            } else if (sub == 2 && (SUBMASK & 4)) {
                const float* gq = inptr(p, 9) + l * 64; const float* gk = inptr(p, 10) + l * 64;
                int col = -1, kind = 0;
                if (lane < 32) { col = 1024 + 8 * lane; kind = 1; } else if (lane < 48) { col = 384 + 8 * (lane - 32); kind = 2; } else if (lane < 52) { col = 896 + 8 * (lane - 48); kind = 3; }
                auto proc = [&](const int row, const u32x4 raw, const u32x4 r2) __attribute__((always_inline)) {
                    bf16_t* hr = H + (long)row * HW;
                    const int pos = tok_pos(row);
                    float y[8];
                    y[0] = bflo(raw.x); y[1] = bfhi(raw.x); y[2] = bflo(raw.y); y[3] = bfhi(raw.y); y[4] = bflo(raw.z); y[5] = bfhi(raw.z); y[6] = bflo(raw.w); y[7] = bfhi(raw.w);
                    float ss = 0.f;
#pragma unroll
                    for (int e = 0; e < 8; ++e) ss += y[e] * y[e];
                    ss += __shfl_xor(ss, 1); ss += __shfl_xor(ss, 2); ss += __shfl_xor(ss, 4);
                    const int j = lane & 7;
                    if (kind == 1 || kind == 2) {
                        const float rs = rsqrtf(ss * (1.f / 64.f) + EPS) * (kind == 1 ? 0.125f * LOG2E : 1.f);
                        const float* gg = (kind == 1 ? gq : gk) + 8 * j;
#pragma unroll
                        for (int e = 0; e < 8; ++e) y[e] = y[e] * rs * gg[e];
                    }
                    const int rp = (kind == 3) ? pos : ((j < 4) ? (pos >> 6) : (pos & 63));
                    const bool isx2 = (j & 2) != 0;
                    const float* tb = rope + ((long)rp * 16 + 8 * (j & 1)) * 2;
#pragma unroll
                    for (int e = 0; e < 8; ++e) {
                        const float pvv = __shfl_xor(y[e], 2);
                        const float c = tb[2 * e], s = tb[2 * e + 1];
                        y[e] = isx2 ? (y[e] * c + pvv * s) : (y[e] * c - pvv * s);
                    }
                    if (kind) { u32x4 o; o.x = pk2(y[0], y[1]); o.y = pk2(y[2], y[3]); o.z = pk2(y[4], y[5]); o.w = pk2(y[6], y[7]); *(u32x4*)(hr + col) = o; }
                };
                const u32x4 zero4 = (u32x4){0u, 0u, 0u, 0u};
                for (int row0 = gw; row0 < MTOK; row0 += 4 * ngw) {
                    u32x4 raw[4], r2[4];
#pragma unroll
                    for (int q = 0; q < 4; ++q) {
                        const int row = row0 + q * ngw; raw[q] = zero4; r2[q] = zero4;
                        if (row < MTOK) {
                            const GAS bf16_t* hr = gptr(H) + (long)row * HW;
                            if (kind) raw[q] = *(const GAS u32x4*)(hr + col);
                        }
                    }
#pragma unroll
                    for (int q = 0; q < 4; ++q) { const int row = row0 + q * ngw; if (row < MTOK) proc(row, raw[q], r2[q]); }
                }
                {
                    SchedStd S; S.o.init(192, 2); S.A = (const char*)(H + 512); S.B = (const char*)(wl + WL_QUP); S.astride = 256L * HW * 2; S.bstride = 256L * 256 * 2;
                    EpiQup E{QB, sqq, rope};
                    pg8::gemm_phase<false>(lds3, wid, 256, HW, 256, S, E);
                }
                {
                    SchedStd S; S.o.init(192, 1); S.A = (const char*)(H + 768); S.B = (const char*)(wl + WL_KUP); S.astride = 256L * HW * 2; S.bstride = 0;
                    EpiScaleStore<0> E{KBN, 256, sqkv, 1.f / 128.f, 256, nullptr, nullptr};
                    pg8::gemm_phase<false>(lds3, wid, 128, HW, 128, S, E);
                }
                {
                    SchedStd S; S.o.init(1, 192); S.A = (const char*)(wl + WL_VUP); S.B = (const char*)(H + 768); S.astride = 0; S.bstride = 256L * HW * 2;
                    EpiScaleStore<1> E{VT + 512L * MTOK, MTOK, sqkv, 1.f / 128.f, MTOK, nullptr, nullptr};
                    pg8::gemm_phase<false>(lds3, wid, 128, 128, HW, S, E);
                }
            } else if (sub == 3 && (SUBMASK & 8)) {
                if (l == 0) { for (long i = gtid; i < 2L * MTOK; i += gthreads) stat[(long)ST_SQQ * MTOK + i] = 0.f; }
                int* sh_u = (int*)(smem + LDS_MISC);
                const float lam = ((const float*)ctl)[CW_LAM + l];
                const float lam_init = 0.8f - 0.6f * expf(-0.3f * (float)l);
#define ATTN_QUEUE(QI, NUNITS, NP, BODY) \
                for (;;) { \
                      \
                    if (wid == 0) { \
                        const int ln_ = lane_id(); \
                        unsigned* cb_ = ctl + CW_ATTN_CTR + 1024 * rep + 64 * (4 * l + QI); \
                        const unsigned c_ = (ln_ < 8) ? __hip_atomic_load(cb_ + ((myx + ln_) & 7), __ATOMIC_RELAXED, __HIP_MEMORY_SCOPE_AGENT) : (unsigned)(NUNITS); \
                        const unsigned long long m_ = __ballot(c_ < (unsigned)(NUNITS)); \
                        int res_ = -1; \
                        if (m_) { const int x_ = (myx + (__ffsll((long long)m_) - 1)) & 7; \
                            unsigned u_ = 0u; if (ln_ == 0) u_ = atomicAdd(cb_ + x_, 1u); u_ = (unsigned)__shfl((int)u_, 0); \
                            res_ = (u_ < (unsigned)(NUNITS)) ? ((x_ << 8) | (int)u_) : -2; } \
                        if (ln_ == 0) *sh_u = res_; \
                    } \
                    __syncthreads(); \
                    const int r_ = *sh_u; \
                    __syncthreads(); \
                    if (r_ == -1) break; \
                    if (r_ == -2) continue; \
                    const int xcd = r_ >> 8, u = r_ & 255; \
                    int h, qb, S; long row0; \
                      \
                    if (u < (NP)) { const int ix = (u >> 4) * 8 + xcd; h = ((NUNITS) == 96) ? (ix & 3) : 2 * (ix & 1); qb = u & 15; row0 = (long)(((NUNITS) == 96) ? (ix >> 2) : (ix >> 1)) * SEQP; S = SEQP; } \
                    else { const int v = u - (NP); const int ix = (v >> 3) * 8 + xcd; h = ((NUNITS) == 96) ? (ix & 3) : 2 * (ix & 1); qb = v & 7; row0 = MPROMPT + (long)(((NUNITS) == 96) ? (ix >> 2) : (ix >> 1)) * SEQS; S = SEQS; } \
                    AttnArgs a; \
                    a.row0 = row0; a.S = S; a.q0 = qb * 256; a.K2 = H; a.ldk2 = 0; a.sink2 = 0.f; a.lam = 0.f; a.post = 0.f; a.subn = inptr(p, 15); a.slope2 = 0.f; \
                    BODY \
                }
                const int myx = (int)(xb_xcc_id() & 7u);
                for (int rep = 0; rep < PROBE_ATTN; ++rep) {
                if ((ATMODE & 8) && (rep == 0 || (PROBE_WHICH & 8))) ATTN_QUEUE(0, 96, 64, {
                    a.Q = H + 1280 + h * 64; a.ldq = HW; a.K = H + 1536 + h * 64; a.ldk = HW; a.VT = VT + (long)(256 + h * 64) * MTOK; a.O = ATT + 768 + h * 64;
                    a.slope2 = exp2f(-(float)(h + 5)) * LOG2E; a.lam = lam; a.post = 1.f - lam_init; a.subn = inptr(p, 15) + l * 64;
                    attn_unit<3>(a, smem, wid * 64 + lane_id()); })
                if ((ATMODE & 2) && (rep == 0 || (PROBE_WHICH & 2))) ATTN_QUEUE(1, 96, 64, {
                    a.Q = QB + h * 96; a.ldq = 384; a.K = KBN + h * 64; a.ldk = 256; a.K2 = H + 896; a.ldk2 = HW; a.VT = VT + (long)(512 + h * 64) * MTOK; a.O = ATT + 256 + h * 64;
                    attn_unit<1>(a, smem, wid * 64 + lane_id()); })
                if ((ATMODE & 4) && (rep == 0 || (PROBE_WHICH & 4))) ATTN_QUEUE(2, 48, 32, {
                    a.Q = H + 1024 + h * 64; a.ldq = HW; a.K = H + 384 + (h >> 1) * 64; a.ldk = HW; a.VT = VT + (long)(128 + (h >> 1) * 64) * MTOK; a.O = ATT + 512 + h * 64;
                    attn_unit_pairC(a, smem, wid * 64 + lane_id()); })
                if ((ATMODE & 1) && (rep == 0 || (PROBE_WHICH & 1))) ATTN_QUEUE(3, 96, 64, {
                    a.Q = H + h * 64; a.ldq = HW; a.K = H + 256 + (h >> 1) * 64; a.ldk = HW; a.VT = VT + (long)((h >> 1) * 64) * MTOK; a.O = ATT + h * 64;
                    a.slope2 = exp2f(-(float)(h + 1)) * LOG2E; a.sink2 = inptr(p, 4)[l * 4 + h] * LOG2E;
                    attn_unit<0>(a, smem, wid * 64 + lane_id()); })
                }
#undef ATTN_QUEUE
            } else if (sub == 4 && (SUBMASK & 16)) {
                EpiResid E{l == 0 ? inptr(p, 0) : pout, l == 0 ? inptr(p, 1) : pout + (long)MPROMPT * DMODEL, pout, XB, rs_ffn};
                SchedStd S; S.o.init(192, 4); S.A = (const char*)ATT; S.B = (const char*)(wl + WL_OUT); S.astride = 256L * DMODEL * 2; S.bstride = 256L * DMODEL * 2;
                pg8::gemm_phase<false>(lds3, wid, DMODEL, DMODEL, DMODEL, S, E);
            } else if (sub == 5 && (SUBMASK & 32)) {
                EpiConvGate E{Gb, rs_ffn, inptr(p, 19) + (long)l * DFF2, (const float*)(ws + WS_CP) + (long)l * DFF * 8, (float*)(smem + LDS_XCH)};
                SchedStd S; S.o.init(194, 22); S.A = (const char*)(XB - DMODEL); S.B = (const char*)(wl + WL_UP); S.astride = 254L * DMODEL * 2; S.bstride = 256L * DMODEL * 2;
                pg8::gemm_phase<true>(lds3, wid, DMODEL, DMODEL, DMODEL, S, E); if (PROBE_GEMM > 1) pg8::gemm_phase<true>(lds3, wid, DMODEL, DMODEL, DMODEL, S, E);
            } else if (sub == 6 && (SUBMASK & 64)) {
                EpiResid E{pout, pout + (long)MPROMPT * DMODEL, pout, XB, l == 0 ? stat + ST_ATTN1 * MTOK : nullptr};
                SchedStd S; S.o.init(192, 4); S.A = (const char*)Gb; S.B = (const char*)(wl + WL_DOWN); S.astride = 256L * DFF * 2; S.bstride = 256L * DFF * 2;
                pg8::gemm_phase<false>(lds3, wid, DFF, DFF, DFF, S, E);
            }
        }
}

__global__ void __launch_bounds__(NTHREADS) fwd_kernel(Params p) {
    extern __shared__ __attribute__((aligned(16))) unsigned char smem[];
    const int wid = __builtin_amdgcn_readfirstlane((int)(threadIdx.x >> 6));
    const int lo = p.ph_lo, hi = p.ph_hi;
    if (lo < -5) cg::this_grid().sync();
    { volatile LAS unsigned* st0 = (volatile LAS unsigned*)((LAS unsigned char*)smem + LDS_MISC + 16); if (wid == 0 && lane_id() < 4) st0[lane_id()] = 0u; }
    __syncthreads();
    const XcdBarrier xbar = xcd_barrier_post((unsigned*)(p.ws + WS_CTL) + CW_XBAR, (volatile LAS unsigned*)((LAS unsigned char*)smem + LDS_MISC + 16), wid);
#define RUN(k) if (lo <= (k) && (k) < hi && (k) != 2 && (k) != 9) { run_phase<k>(p, wid, smem); if ((k) == 0 && PROBE_P0 > 1) run_phase<k>(p, wid, smem); if ((k) + 1 < hi) { for (int r_ = 0; r_ < PROBE_BAR; ++r_) xcd_barrier(xbar, wid); } }
    RUN(0) RUN(1) RUN(2) RUN(3) RUN(4) RUN(5) RUN(6) RUN(7) RUN(8) RUN(9) RUN(10) RUN(11) RUN(12) RUN(13) RUN(14) RUN(15)
#undef RUN
}

extern "C" void kernel_launch(void* const* d_in, const int* in_sizes, int n_in, void* d_out, int out_size, void* d_ws, size_t ws_size, hipStream_t stream) {
    static int grid = 0;
    if (grid == 0) {
        if (n_in != 24 || out_size != MTOK * DMODEL || ws_size < WS_END) { fprintf(stderr, "kernel_launch: unexpected shapes (n_in %d out %d ws %zu)\n", n_in, out_size, ws_size); grid = -1; return; }
        int dev = 0, cus = 0, per_cu = 0;
        hipGetDevice(&dev);
        hipDeviceGetAttribute(&cus, hipDeviceAttributeMultiprocessorCount, dev);
        if (hipFuncSetAttribute((const void*)fwd_kernel, hipFuncAttributeMaxDynamicSharedMemorySize, LDS_BYTES) != hipSuccess) { fprintf(stderr, "hipFuncSetAttribute failed\n"); grid = -1; return; }
        hipOccupancyMaxActiveBlocksPerMultiprocessor(&per_cu, (const void*)fwd_kernel, NTHREADS, LDS_BYTES);
        if (per_cu < 1) per_cu = 1;
        if (per_cu > 1) per_cu = 1;
        grid = cus * per_cu;
    }
    if (grid < 0) return;
    hipMemsetAsync((char*)d_ws + WS_CTL, 0, 32768, stream);
    Params p{};
    for (int i = 0; i < 24; ++i) p.in[i] = (const float*)d_in[i];
    p.out = (float*)d_out; p.ws = (unsigned char*)d_ws;
#if ONE_LAUNCH
    p.ph_lo = 0; p.ph_hi = NPHASES;
    void* args[] = {&p};
    hipError_t e = hipLaunchCooperativeKernel((const void*)fwd_kernel, dim3(grid), dim3(NTHREADS), args, LDS_BYTES, stream);
    if (e != hipSuccess) fprintf(stderr, "cooperative launch failed: %s (grid %d)\n", hipGetErrorString(e), grid);
#else
    for (int ph = 0; ph < NPHASES; ++ph) {
        p.ph_lo = ph; p.ph_hi = ph + 1;
        hipLaunchKernelGGL(fwd_kernel, dim3(grid), dim3(NTHREADS), LDS_BYTES, stream, p);
    }
#endif
}
```

```cpp
#include <hip/hip_runtime.h>
#include <hip/hip_cooperative_groups.h>
#include <cstdio>
#include <cstdint>
namespace cg = cooperative_groups;

#ifndef SUBMASK
#define SUBMASK 0xffff
#endif
#ifndef SUB2B
#define SUB2B 7
#endif
#ifndef ATMODE
#define ATMODE 15
#endif
#ifndef PROBE_ATTN
#define PROBE_ATTN 1
#endif
#ifndef PROBE_GEMM
#define PROBE_GEMM 1
#endif
#ifndef PROBE_P0
#define PROBE_P0 1
#endif
#ifndef PROBE_BAR
#define PROBE_BAR 1
#endif
#ifndef PROBE_WHICH
#define PROBE_WHICH 15
#endif
#ifndef ONE_LAUNCH
#define ONE_LAUNCH 1
#endif

#define DI __device__ __forceinline__
typedef unsigned short bf16_t;
typedef short bf16x8 __attribute__((ext_vector_type(8)));
typedef short s16x4 __attribute__((ext_vector_type(4)));
typedef float f32x4 __attribute__((ext_vector_type(4)));
typedef float f32x16 __attribute__((ext_vector_type(16)));
typedef unsigned u32x4 __attribute__((ext_vector_type(4)));
typedef unsigned u32x2 __attribute__((ext_vector_type(2)));
typedef float f32x2_t __attribute__((ext_vector_type(2)));
typedef __bf16 bf16x2_t __attribute__((ext_vector_type(2)));

DI unsigned pk2(float lo, float hi) { f32x2_t v = {lo, hi}; bf16x2_t b = __builtin_convertvector(v, bf16x2_t); return __builtin_bit_cast(unsigned, b); }
#define GAS __attribute__((address_space(1)))
#define LAS __attribute__((address_space(3)))
template <class T> DI GAS T* gptr(T* p) { return (GAS T*)p; }
template <class T> DI const GAS T* gptr(const T* p) { return (const GAS T*)p; }
DI int lane_id() { int l = (int)__builtin_amdgcn_mbcnt_hi(~0u, __builtin_amdgcn_mbcnt_lo(~0u, 0u)); asm volatile("" : "+v"(l)); return l; }
DI float bflo(unsigned u) { return __uint_as_float(u << 16); }
DI float bfhi(unsigned u) { return __uint_as_float(u & 0xffff0000u); }

constexpr int DMODEL = 1024, MTOK = 49152, MPROMPT = 32768, SEQP = 4096, SEQS = 2048;
constexpr int INW = 2208, HW = 1792, DFF = 2816, DFF2 = 5632;
constexpr float EPS = 1e-6f;
constexpr float LOG2E = 1.4426950408889634f;
constexpr int NTHREADS = 512;
constexpr int NPHASES = 16;

constexpr size_t MiB = 1u << 20;
constexpr size_t WS_CTL = 0;
constexpr size_t WS_STAT = 1 * MiB;
constexpr size_t WS_CP = 1 * MiB + 1536 * 1024;
constexpr size_t WS_ROPE = 3 * MiB;
constexpr size_t WS_W = 4 * MiB;
constexpr size_t WL_IN = 0, WL_QUP = 4718592, WL_KUP = WL_QUP + 262144, WL_VUP = WL_KUP + 65536, WL_OUT = WL_VUP + 65536,
                 WL_UP = WL_OUT + 2097152, WL_DOWN = WL_UP + 11534336, WL_STRIDE = 24 * MiB;
static_assert(WL_DOWN + 5767168 <= WL_STRIDE, "weights per layer");
constexpr size_t WS_H = 52 * MiB;
constexpr size_t WS_VT = 220 * MiB;
constexpr size_t WS_G = 52 * MiB;
constexpr size_t WS_XB = 317 * MiB;
constexpr size_t WS_QB = WS_XB;
constexpr size_t WS_KBN = WS_XB + 36 * MiB;
constexpr size_t WS_ATT = 414 * MiB;
constexpr size_t WS_END = 510 * MiB;
constexpr int ST_ATTN0 = 0, ST_FFN0 = 1, ST_ATTN1 = 2, ST_FFN1 = 3, ST_SQQ = 4, ST_SQKV = 5;
constexpr int CW_ATTN_CTR = 0;
constexpr int CW_LAM = 600;
constexpr int CW_GBAR = 704;
constexpr int CW_XBAR = 4096;

constexpr int LDS_XCH = 131072, LDS_MISC = LDS_XCH + 4096, LDS_BYTES = LDS_MISC + 64;
struct Params {
    const float* in[24];
    float* out;
    unsigned char* ws;
    int ph_lo, ph_hi;
};

namespace pg8 {
#define PG8_LAS __attribute__((address_space(3)))
constexpr int BM = 256, BK = 64, HALF = 128, HTB = HALF * BK * 2  , STAGE_BYTES = 8 * HTB, NXCD = 8, WGM = 8;

__host__ __device__ __forceinline__ int lds_byte(int r, int c) { const int st = (r >> 4) * 2 + (c >> 5), rr = r & 15, cc = c & 31, ob = rr * 64 + cc * 2; return st * 1024 + (ob ^ (((ob >> 9) & 1) << 5)); }
__host__ __device__ __forceinline__ void stage_rc(int b, int& R, int& C) { const int st = b / 1024, sb = b % 1024, swz = sb ^ (((sb >> 9) & 1) << 5); R = (st >> 1) * 16 + swz / 64; C = (st & 1) * 32 + (swz % 64) / 2; }
__host__ __device__ __forceinline__ int perm32(int rho) { const int n = rho >> 4, i = rho & 15; return 8 * (i >> 2) + 4 * n + (i & 3); }
struct Unit { const char* A; const char* B; int pm, pn; };
template <bool PERMROWS, class Epi, class Sched>
__device__ __forceinline__ void gemm_phase(PG8_LAS unsigned char* lds, const int wid, const int K, const int lda, const int ldb, const Sched& S, const Epi& E) {
    constexpr bool ALIGN_EPI = true, SP2 = true;
    const int lane = lane_id(), tid = wid * 64 + lane, wr = wid >> 2, wc = wid & 3, fr = lane & 15, fq = lane >> 4;
    const int nt = K / BK;
    unsigned voffA[2], voffB[2];
#pragma unroll
    for (int i = 0; i < 2; ++i) { int R, C; stage_rc(tid * 16 + i * 8192, R, C); const int Rb = (R & ~31) + perm32(R & 31);
        const int Ra = PERMROWS ? (8 * (16 * (R >> 6) + (R & 15)) + ((R >> 4) & 3)) : R;
        voffA[i] = (unsigned)(Ra * lda + C) * 2u; voffB[i] = (unsigned)(Rb * ldb + C) * 2u; }
    const size_t kstep = (size_t)(BK * 2);
    const size_t hstepA = (size_t)(PERMROWS ? 4 : HALF) * lda * 2, hstepB = (size_t)HALF * ldb * 2;
    const unsigned ldsw = (unsigned)wid * 1024u;
    const int aoff = lds_byte(wr * 64 + fr, fq * 8), boff = lds_byte(wc * 32 + fr, fq * 8);
#define PG8_SA(b, h) (((b) * 2 + (h)) * HTB)
#define PG8_SB(b, h) ((4 + (b) * 2 + (h)) * HTB)
#define PG8_STAGE(bufoff, gbase, voff) do { _Pragma("unroll") for (int _i = 0; _i < 2; ++_i) \
        __builtin_amdgcn_global_load_lds((const unsigned*)((const char*)(gbase) + (voff)[_i]), (PG8_LAS unsigned*)(lds + (bufoff) + ldsw + _i * 8192), 16, 0, 0); } while (0)
#define PG8_LDA(dst, b, h) do { _Pragma("unroll") for (int m = 0; m < 4; ++m) _Pragma("unroll") for (int k = 0; k < 2; ++k) dst[m][k] = *(const PG8_LAS bf16x8*)(lds + PG8_SA(b, h) + aoff + m * 2048 + k * 1024); } while (0)
#define PG8_LDB(dst, b, h) do { _Pragma("unroll") for (int n = 0; n < 2; ++n) _Pragma("unroll") for (int k = 0; k < 2; ++k) dst[n][k] = *(const PG8_LAS bf16x8*)(lds + PG8_SB(b, h) + boff + n * 2048 + k * 1024); } while (0)
#define PG8_MMA(ai, bj, At, Bt) do { __builtin_amdgcn_s_setprio(1); _Pragma("unroll") for (int m = 0; m < 4; ++m) _Pragma("unroll") for (int n = 0; n < 2; ++n) _Pragma("unroll") for (int k = 0; k < 2; ++k) \
        acc[ai][bj][m][n] = __builtin_amdgcn_mfma_f32_16x16x32_bf16(Bt[n][k], At[m][k], acc[ai][bj][m][n], 0, 0, 0); __builtin_amdgcn_s_setprio(0); } while (0)
#define PG8_WAIT_V(n) asm volatile("s_waitcnt vmcnt(" #n ")" ::: "memory")
#define PG8_WAIT_L(n) asm volatile("s_waitcnt lgkmcnt(" #n ")" ::: "memory")
#define PG8_BAR __builtin_amdgcn_s_barrier()
#define PG8_SCHED __builtin_amdgcn_sched_barrier(0)
    Unit cur, nxt; int ui = 0;
    if (!S.next(0, cur)) return;
    f32x4 acc[2][2][4][2];
#pragma unroll
    for (int a = 0; a < 2; ++a)
#pragma unroll
        for (int b = 0; b < 2; ++b)
#pragma unroll
            for (int m = 0; m < 4; ++m)
#pragma unroll
                for (int n = 0; n < 2; ++n) acc[a][b][m][n] = (f32x4){0.f, 0.f, 0.f, 0.f};
    bf16x8 At[4][2], B0[2][2], B1[2][2];
    const char* cA = cur.A; const char* cB = cur.B;
    if constexpr (SP2) {
        PG8_STAGE(PG8_SB(0, 0), cB, voffB); PG8_STAGE(PG8_SB(0, 1), cB + hstepB, voffB); PG8_STAGE(PG8_SA(0, 0), cA, voffA); PG8_STAGE(PG8_SA(0, 1), cA + hstepA, voffA);
        if (wr == 1) PG8_BAR;
        PG8_WAIT_V(2); PG8_BAR;
        PG8_STAGE(PG8_SB(1, 0), cB + kstep, voffB); PG8_STAGE(PG8_SA(1, 0), cA + kstep, voffA); PG8_STAGE(PG8_SB(1, 1), cB + hstepB + kstep, voffB);
        PG8_WAIT_V(6); PG8_BAR;
    } else {
        PG8_STAGE(PG8_SB(0, 0), cB, voffB); PG8_STAGE(PG8_SA(0, 0), cA, voffA); PG8_STAGE(PG8_SB(0, 1), cB + hstepB, voffB); PG8_STAGE(PG8_SA(0, 1), cA + hstepA, voffA);
        if (wr == 1) PG8_BAR;
        PG8_WAIT_V(4); PG8_BAR;
        PG8_STAGE(PG8_SB(1, 0), cB + kstep, voffB); PG8_STAGE(PG8_SA(1, 0), cA + kstep, voffA); PG8_STAGE(PG8_SB(1, 1), cB + hstepB + kstep, voffB);
        PG8_WAIT_V(6); PG8_BAR;
    }
    for (;;) {
        const bool has_next = S.next(ui + 1, nxt);
        const char* nA = has_next ? nxt.A : cA; const char* nB = has_next ? nxt.B : cB;
#pragma unroll 1
        for (int t = 0; t < nt; t += 2) {
            const bool last = (t == nt - 2);
            const char* a1 = cA + (size_t)(t + 1) * kstep;
            const char* a2 = last ? nA : cA + (size_t)(t + 2) * kstep; const char* b2 = last ? nB : cB + (size_t)(t + 2) * kstep;
            const char* a3 = a2 + kstep; const char* b3 = b2 + kstep;
            if constexpr (SP2) {
            PG8_LDB(B0, 0, 0); PG8_LDB(B1, 0, 1); PG8_SCHED; PG8_LDA(At, 0, 0); PG8_STAGE(PG8_SA(1, 1), a1 + hstepA, voffA);
            PG8_WAIT_V(8); PG8_WAIT_L(0); PG8_BAR; PG8_MMA(0, 0, At, B0); PG8_MMA(0, 1, At, B1); PG8_BAR; PG8_SCHED;
            PG8_LDA(At, 0, 1); PG8_STAGE(PG8_SB(0, 0), b2, voffB); PG8_STAGE(PG8_SB(0, 1), b2 + hstepB, voffB); PG8_STAGE(PG8_SA(0, 0), a2, voffA);
            PG8_WAIT_V(8); PG8_WAIT_L(0); PG8_BAR; PG8_MMA(1, 0, At, B0); PG8_MMA(1, 1, At, B1); PG8_BAR; PG8_SCHED;
            PG8_LDB(B0, 1, 0); PG8_LDB(B1, 1, 1); PG8_SCHED; PG8_LDA(At, 1, 0); PG8_STAGE(PG8_SA(0, 1), a2 + hstepA, voffA);
            PG8_WAIT_V(8); PG8_WAIT_L(0); PG8_BAR; PG8_MMA(0, 0, At, B0); PG8_MMA(0, 1, At, B1); PG8_BAR; PG8_SCHED;
            PG8_LDA(At, 1, 1); PG8_STAGE(PG8_SB(1, 0), b3, voffB); PG8_STAGE(PG8_SB(1, 1), b3 + hstepB, voffB); PG8_STAGE(PG8_SA(1, 0), a3, voffA);
            PG8_WAIT_V(8); PG8_WAIT_L(0); PG8_BAR; PG8_MMA(1, 0, At, B0); PG8_MMA(1, 1, At, B1); PG8_BAR; PG8_SCHED;
            } else {
            PG8_LDB(B0, 0, 0); PG8_SCHED; PG8_LDA(At, 0, 0); PG8_STAGE(PG8_SA(1, 1), a1 + hstepA, voffA);
            PG8_WAIT_L(8); PG8_BAR; PG8_WAIT_L(0); PG8_MMA(0, 0, At, B0); PG8_BAR; PG8_SCHED;
            PG8_LDB(B1, 0, 1); PG8_STAGE(PG8_SB(0, 0), b2, voffB);
            PG8_BAR; PG8_WAIT_L(0); PG8_MMA(0, 1, At, B1); PG8_BAR;
            PG8_LDA(At, 0, 1); PG8_STAGE(PG8_SA(0, 0), a2, voffA);
            PG8_BAR; PG8_WAIT_L(0); PG8_MMA(1, 0, At, B0); PG8_BAR; PG8_SCHED;
            PG8_STAGE(PG8_SB(0, 1), b2 + hstepB, voffB);
            PG8_WAIT_V(6); PG8_BAR; PG8_MMA(1, 1, At, B1); PG8_BAR;
            PG8_LDB(B0, 1, 0); PG8_SCHED; PG8_LDA(At, 1, 0); PG8_STAGE(PG8_SA(0, 1), a2 + hstepA, voffA);
            PG8_WAIT_L(8); PG8_BAR; PG8_WAIT_L(0); PG8_MMA(0, 0, At, B0); PG8_BAR; PG8_SCHED;
            PG8_LDB(B1, 1, 1); PG8_STAGE(PG8_SB(1, 0), b3, voffB);
            PG8_BAR; PG8_WAIT_L(0); PG8_MMA(0, 1, At, B1); PG8_BAR;
            PG8_LDA(At, 1, 1); PG8_STAGE(PG8_SA(1, 0), a3, voffA);
            PG8_BAR; PG8_WAIT_L(0); PG8_MMA(1, 0, At, B0); PG8_BAR; PG8_SCHED;
            PG8_STAGE(PG8_SB(1, 1), b3 + hstepB, voffB);
            PG8_WAIT_V(6); PG8_BAR; PG8_MMA(1, 1, At, B1); PG8_BAR;
            }
        }
        if constexpr (ALIGN_EPI) { if (wr == 0) PG8_BAR; }
        E(acc, cur, wr, wc);
        if (!has_next) break;
#pragma unroll
        for (int a = 0; a < 2; ++a)
#pragma unroll
            for (int b = 0; b < 2; ++b)
#pragma unroll
                for (int m = 0; m < 4; ++m)
#pragma unroll
                    for (int n = 0; n < 2; ++n) acc[a][b][m][n] = (f32x4){0.f, 0.f, 0.f, 0.f};
        cur = nxt; cA = nA; cB = nB; ++ui;
        if constexpr (ALIGN_EPI) { if (wr == 1) PG8_BAR; }
    }
    PG8_WAIT_V(0);
    if constexpr (!ALIGN_EPI) { if (wr == 0) PG8_BAR; }
    PG8_BAR;
#undef PG8_SA
#undef PG8_SB
#undef PG8_STAGE
#undef PG8_LDA
#undef PG8_LDB
#undef PG8_MMA
#undef PG8_WAIT_V
#undef PG8_WAIT_L
#undef PG8_BAR
#undef PG8_SCHED
}
}

struct Order {
    int nM, nN, nwg, G, c, rev;
    DI void init(int nM_, int nN_, int rev_ = 0) { nM = nM_; nN = nN_; nwg = nM * nN; G = gridDim.x; c = blockIdx.x; rev = rev_; }
    DI bool next(int i, int& pm, int& pn) const {
        const long L = (long)i * G + c; if (L >= nwg) return false;
        int wgid = (int)L; { const int q = nwg / 8, r = nwg % 8, xcd = wgid % 8, off = wgid / 8; wgid = (xcd < r ? xcd * (q + 1) : r * (q + 1) + (xcd - r) * q) + off; }
        const int nig = 8 * nN, gid = wgid / nig, fm = gid * 8, gsz = (nM - fm) < 8 ? (nM - fm) : 8;
        pm = fm + ((wgid % nig) % gsz); pn = (wgid % nig) / gsz; if (rev) pm = nM - 1 - pm; return true;
    }
};
struct SchedStd {
    Order o; const char* A; const char* B; long astride, bstride;
    DI bool next(int i, pg8::Unit& u) const { int pm, pn; if (!o.next(i, pm, pn)) return false; u.pm = pm; u.pn = pn; u.A = A + pm * astride; u.B = B + pn * bstride; return true; }
};
struct SchedInproj {
    Order o; const char* XB; const char* W;
    DI bool next(int i, pg8::Unit& u) const { int pm, pn; if (!o.next(i, pm, pn)) return false; u.pm = pm; u.pn = pn;
        const char* xt = XB + (long)pm * 256 * DMODEL * 2;
        if (pn < 7) { u.A = xt; u.B = W + (long)pn * 256 * DMODEL * 2; } else { u.A = W + (long)(1792 + 256 * (pn - 7)) * DMODEL * 2; u.B = xt; }
        return true; }
};
template <int MODE>
struct EpiScaleStore {
    bf16_t* O; int ldo; const float* rsum; float invn; int ncols; float* sq0; float* sq1;
    DI void operator()(f32x4 (&acc)[2][2][4][2], const pg8::Unit& u, int wr, int wc) const { (*this)(acc, 256 * u.pm, 256 * u.pn, wr, wc); }
    DI void operator()(f32x4 (&acc)[2][2][4][2], int row0, int col0, int wr, int wc) const {
        const int lane_ = lane_id(), fr = lane_ & 15, fq = lane_ >> 4;
        float cs[2][8];
        if (MODE == 1) {
#pragma unroll
            for (int bj = 0; bj < 2; ++bj)
#pragma unroll
                for (int j = 0; j < 8; ++j) cs[bj][j] = rsqrtf(gptr(rsum)[(unsigned)(col0 + 128 * bj + 32 * wc + 8 * fq + j)] * invn + EPS);
        }
#pragma unroll
        for (int ai = 0; ai < 2; ++ai)
#pragma unroll
            for (int m = 0; m < 4; ++m) {
                const int row = row0 + 128 * ai + 64 * wr + 16 * m + fr;
                float rs = 1.f, ssq = 0.f;
                if (MODE == 0) rs = rsqrtf(gptr(rsum)[(unsigned)row] * invn + EPS);
#pragma unroll
                for (int bj = 0; bj < 2; ++bj) {
                    const int col = col0 + 128 * bj + 32 * wc + 8 * fq;
                    if (col >= ncols) continue;
                    f32x4 v0 = acc[ai][bj][m][0], v1 = acc[ai][bj][m][1];
                    if (MODE == 0) { v0 = v0 * rs; v1 = v1 * rs; }
                    else { v0 = v0 * (f32x4){cs[bj][0], cs[bj][1], cs[bj][2], cs[bj][3]}; v1 = v1 * (f32x4){cs[bj][4], cs[bj][5], cs[bj][6], cs[bj][7]}; }
                    u32x4 w; w.x = pk2(v0[0], v0[1]); w.y = pk2(v0[2], v0[3]); w.z = pk2(v1[0], v1[1]); w.w = pk2(v1[2], v1[3]);
                    *(GAS u32x4*)(gptr(O) + (unsigned)(row * ldo + col)) = w;
                    if (MODE == 0 && sq0 && (col0 == 512 || (col0 == 768 && bj == 0)))
                        ssq += (v0[0] * v0[0] + v0[1] * v0[1]) + (v0[2] * v0[2] + v0[3] * v0[3]) + (v1[0] * v1[0] + v1[1] * v1[1]) + (v1[2] * v1[2] + v1[3] * v1[3]);
                }
                if (MODE == 0 && sq0 && (col0 == 512 || col0 == 768)) {
                    ssq += __shfl_xor(ssq, 16); ssq += __shfl_xor(ssq, 32);
                    if (fq == 0 && (col0 == 512 || wc < 4)) atomicAdd((col0 == 512 ? sq0 : sq1) + row, ssq);
                }
                asm volatile("" ::: "memory");
            }
    }
};

struct EpiInproj {
    EpiScaleStore<0> eh; EpiScaleStore<1> ev;
    DI void operator()(f32x4 (&acc)[2][2][4][2], const pg8::Unit& u, int wr, int wc) const {
        if (u.pn < 7) eh(acc, 256 * u.pm, 256 * u.pn, wr, wc); else ev(acc, 256 * (u.pn - 7), 256 * u.pm, wr, wc);
    }
};
DI int tok_pos(int row) { return row < MPROMPT ? (row & (SEQP - 1)) : (row & (SEQS - 1)); }

struct EpiQup {
    bf16_t* QB; const float* sq; const float* rope;
    DI void operator()(f32x4 (&acc)[2][2][4][2], const pg8::Unit& u, int wr, int wc) const { (*this)(acc, 256L * u.pm, 256L * u.pn, wr, wc); }
    DI void operator()(f32x4 (&acc)[2][2][4][2], long row0, long col0, int wr, int wc) const {
        const int lane_ = lane_id(), fr = lane_ & 15, fq = lane_ >> 4;
#pragma unroll
        for (int ai = 0; ai < 2; ++ai)
#pragma unroll
            for (int m = 0; m < 4; ++m) {
                const int row = (int)row0 + 128 * ai + 64 * wr + 16 * m + fr;
                const float rs = rsqrtf(gptr(sq)[(unsigned)row] * (1.f / 256.f) + EPS);
                const int pos = tok_pos(row);
#pragma unroll
                for (int bj = 0; bj < 2; ++bj) {
                    const int col = (int)col0 + 128 * bj + 32 * wc + 8 * fq;
                    if (col >= 384) continue;
                    const f32x4 v0 = acc[ai][bj][m][0] * rs, v1 = acc[ai][bj][m][1] * rs;
                    const int head = col / 96, w = col - head * 96;
                    if (w < 64) {
                        u32x4 o; o.x = pk2(v0[0], v0[1]); o.y = pk2(v0[2], v0[3]); o.z = pk2(v1[0], v1[1]); o.w = pk2(v1[2], v1[3]);
                        *(GAS u32x4*)(gptr(QB) + (unsigned)(row * 384 + col)) = o;
                    } else {
                        const int g = (w - 64) >> 3;
                        const GAS f32x4* t = (const GAS f32x4*)(gptr(rope) + (unsigned)((pos * 16 + 4 * g) * 2));
                        const f32x4 t0 = t[0], t1 = t[1];
                        const float c[4] = {t0[0], t0[2], t1[0], t1[2]}, s[4] = {t0[1], t0[3], t1[1], t1[3]};
                        float o1[4], o2[4];
#pragma unroll
                        for (int e = 0; e < 4; ++e) { o1[e] = v0[e] * c[e] - v1[e] * s[e]; o2[e] = v1[e] * c[e] + v0[e] * s[e]; }
                        u32x2 a, b; a.x = pk2(o1[0], o1[1]); a.y = pk2(o1[2], o1[3]); b.x = pk2(o2[0], o2[1]); b.y = pk2(o2[2], o2[3]);
                        GAS bf16_t* q = gptr(QB) + (unsigned)(row * 384 + head * 96 + 64 + 4 * g);
                        *(GAS u32x2*)q = a; *(GAS u32x2*)(q + 16) = b;
                    }
                }
                asm volatile("" ::: "memory");
            }
    }
};

struct EpiResid {
    const float* xo0; const float* xo1; float* out; bf16_t* XB; float* rsum;
    DI void operator()(f32x4 (&acc)[2][2][4][2], const pg8::Unit& u, int wr, int wc) const { (*this)(acc, 256L * u.pm, 256L * u.pn, wr, wc); }
    DI void operator()(f32x4 (&acc)[2][2][4][2], long row0, long col0, int wr, int wc) const {
        const int lane_ = lane_id(), fr = lane_ & 15, fq = lane_ >> 4;
#pragma unroll
        for (int ai = 0; ai < 2; ++ai)
#pragma unroll
            for (int m = 0; m < 4; ++m) {
                const int row = (int)row0 + 128 * ai + 64 * wr + 16 * m + fr;
                const GAS float* xo = row < MPROMPT ? gptr(xo0) + (unsigned)(row * DMODEL) : gptr(xo1) + (unsigned)((row - MPROMPT) * DMODEL);
                float ss = 0.f;
#pragma unroll
                for (int bj = 0; bj < 2; ++bj) {
                    const int col = (int)col0 + 128 * bj + 32 * wc + 8 * fq;
                    const f32x4 v0 = acc[ai][bj][m][0] + *(const GAS f32x4*)(xo + col), v1 = acc[ai][bj][m][1] + *(const GAS f32x4*)(xo + col + 4);
                    *(GAS f32x4*)(gptr(out) + (unsigned)(row * DMODEL + col)) = v0; *(GAS f32x4*)(gptr(out) + (unsigned)(row * DMODEL + col + 4)) = v1;
                    u32x4 w; w.x = pk2(v0[0], v0[1]); w.y = pk2(v0[2], v0[3]); w.z = pk2(v1[0], v1[1]); w.w = pk2(v1[2], v1[3]);
                    *(GAS u32x4*)(gptr(XB) + (unsigned)(row * DMODEL + col)) = w;
                    ss += (v0[0] * v0[0] + v0[1] * v0[1]) + (v0[2] * v0[2] + v0[3] * v0[3]) + (v1[0] * v1[0] + v1[1] * v1[1]) + (v1[2] * v1[2] + v1[3] * v1[3]);
                }
                if (rsum) {
                    ss += __shfl_xor(ss, 16); ss += __shfl_xor(ss, 32);
                    if (fq == 0) atomicAdd(rsum + row, ss);
                }
                asm volatile("" ::: "memory");
            }
    }
};

DI bool seq_start(int g) { return g < MPROMPT ? ((g & (SEQP - 1)) == 0) : ((g & (SEQS - 1)) == 0); }
DI bool seq_end(int g) { return g < MPROMPT ? ((g & (SEQP - 1)) == SEQP - 1) : ((g & (SEQS - 1)) == SEQS - 1); }

struct EpiConvGate {
    bf16_t* G; const float* rsum; const float* bup; const float* cp; float* xch;
    DI void operator()(f32x4 (&acc)[2][2][4][2], const pg8::Unit& u, int wr, int wc) const { (*this)(acc, u.pm, u.pn, wr, wc); }
    DI void operator()(f32x4 (&acc)[2][2][4][2], int pm, int pn, int wr, int wc) const {
        const int lane_ = lane_id(), fr = lane_ & 15, fq = lane_ >> 4;
        const int G16 = 16 * wr + fr;
        const int g0 = 254 * pm - 1 + 8 * G16;
        const int ffb = 128 * pn + 32 * wc + 8 * fq;
        unsigned stm = 0u, enm = 0u;
#pragma unroll
        for (int jj = 0; jj < 8; ++jj) {
            const int g = g0 + jj; const bool ok = (g >= 0 && g < MTOK);
            const float rs = ok ? rsqrtf(gptr(rsum)[(unsigned)(ok ? g : 0)] * (1.f / 1024.f) + EPS) : 0.f;
            stm |= (seq_start(g) ? 1u : 0u) << jj; enm |= (seq_end(g) ? 1u : 0u) << jj;
#pragma unroll
            for (int bj = 0; bj < 2; ++bj)
#pragma unroll
                for (int n = 0; n < 2; ++n) {
                    const f32x4 bias = *(const GAS f32x4*)(gptr(bup) + (unsigned)(bj * DFF + ffb + 4 * n));
                    f32x4 h = acc[jj >> 2][bj][jj & 3][n] * rs + bias;
                    if (!ok) h = (f32x4){0.f, 0.f, 0.f, 0.f};
                    acc[jj >> 2][bj][jj & 3][n] = h;
                }
        }
        LAS f32x4* x0 = (LAS f32x4*)xch;
        if (fr == 15) {
#pragma unroll
            for (int bj = 0; bj < 2; ++bj)
#pragma unroll
                for (int n = 0; n < 2; ++n) x0[(((0 * 2 + wr) * 4 + wc) * 4 + fq) * 4 + bj * 2 + n] = acc[1][bj][3][n];
        }
        if (fr == 0) {
#pragma unroll
            for (int bj = 0; bj < 2; ++bj)
#pragma unroll
                for (int n = 0; n < 2; ++n) x0[(((1 * 2 + wr) * 4 + wc) * 4 + fq) * 4 + bj * 2 + n] = acc[0][bj][0][n];
        }
        asm volatile("s_waitcnt lgkmcnt(0)" ::: "memory"); __builtin_amdgcn_s_barrier(); asm volatile("" ::: "memory");
#pragma unroll
        for (int n = 0; n < 2; ++n) {
            unsigned ci = (unsigned)((ffb + 4 * n) * 2); asm volatile("" : "+v"(ci));
            const GAS f32x4* cpp = (const GAS f32x4*)gptr(cp) + ci;
            f32x4 prm[4][2];
#pragma unroll
            for (int e = 0; e < 4; ++e) { prm[e][0] = cpp[2 * e]; prm[e][1] = cpp[2 * e + 1]; }
            f32x4 pv[2], nx[2];
#pragma unroll
            for (int bj = 0; bj < 2; ++bj) {
#pragma unroll
                for (int e = 0; e < 4; ++e) { pv[bj][e] = __shfl_up(acc[1][bj][3][n][e], 1, 16); nx[bj][e] = __shfl_down(acc[0][bj][0][n][e], 1, 16); }
                if (fr == 0 && wr == 1) pv[bj] = x0[(((0 * 2 + 0) * 4 + wc) * 4 + fq) * 4 + bj * 2 + n];
                if (fr == 15 && wr == 0) nx[bj] = x0[(((1 * 2 + 1) * 4 + wc) * 4 + fq) * 4 + bj * 2 + n];
            }
#pragma unroll
            for (int hf = 0; hf < 2; ++hf) {
                unsigned opk[4][2];
#pragma unroll
                for (int ep = 0; ep < 2; ++ep) {
                    float val[4][2];
#pragma unroll
                    for (int eh = 0; eh < 2; ++eh) {
                        const int e = 2 * ep + eh;
                        const f32x4 pa = prm[e][0], pb = prm[e][1];
                        const float w0a = pa[0], w1a = pa[1], w2a = pa[2], ca0 = pa[3];
                        const float w0b = pb[0], w1b = pb[1], w2b = pb[2], cb0 = pb[3];
#pragma unroll
                        for (int j4 = 0; j4 < 4; ++j4) {
                            const int jj = 4 * hf + j4;
                            float hpa = jj == 0 ? pv[0][e] : acc[(jj - 1) >> 2][0][(jj - 1) & 3][n][e];
                            float hpb = jj == 0 ? pv[1][e] : acc[(jj - 1) >> 2][1][(jj - 1) & 3][n][e];
                            float hna = jj == 7 ? nx[0][e] : acc[(jj + 1) >> 2][0][(jj + 1) & 3][n][e];
                            float hnb = jj == 7 ? nx[1][e] : acc[(jj + 1) >> 2][1][(jj + 1) & 3][n][e];
                            if ((stm >> jj) & 1u) { hpa = 0.f; hpb = 0.f; }
                            if ((enm >> jj) & 1u) { hna = 0.f; hnb = 0.f; }
                            const float ha = acc[jj >> 2][0][jj & 3][n][e], hb = acc[jj >> 2][1][jj & 3][n][e];
                            const float ca = w0a * hpa + w1a * ha + w2a * hna + ca0;
                            const float cbv = w0b * hpb + w1b * hb + w2b * hnb + cb0;
                            val[j4][eh] = ca * __builtin_amdgcn_rcpf(1.f + __expf(-ca)) * cbv;
                        }
                    }
#pragma unroll
                    for (int j4 = 0; j4 < 4; ++j4) opk[j4][ep] = pk2(val[j4][0], val[j4][1]);
                }
#pragma unroll
                for (int j4 = 0; j4 < 4; ++j4) {
                    const int jj = 4 * hf + j4;
                    const int T = 8 * G16 + jj; const int g = g0 + jj;
                    if (T >= 1 && T <= 254 && g < MTOK) { u32x2 w; w.x = opk[j4][0]; w.y = opk[j4][1]; *(GAS u32x2*)(gptr(G) + ((unsigned)g * (unsigned)DFF + (unsigned)(ffb + 4 * n))) = w; }
                }
                asm volatile("" ::: "memory");
            }
            asm volatile("" ::: "memory");
        }
        asm volatile("s_waitcnt lgkmcnt(0)" ::: "memory"); __builtin_amdgcn_s_barrier(); asm volatile("" ::: "memory");
    }
};

constexpr int AT_KLD = 104, AT_VLD = 72;
constexpr int AT_KBUF = 64 * AT_KLD * 2, AT_VBUF = 64 * AT_VLD * 2;
constexpr int AT_VOFF = 2 * AT_KBUF, AT_BYTES = AT_VOFF + 2 * AT_VBUF;
struct AttnArgs {
    const bf16_t* Q; int ldq; const bf16_t* K; int ldk; const bf16_t* K2; int ldk2; const bf16_t* VT; bf16_t* O;
    long row0; int S; int q0; float slope2; float sink2; float lam; float post; const float* subn;
};
DI int crow(int r, int hi) { return (r & 3) + 8 * (r >> 2) + 4 * hi; }
constexpr float NEG_BIG = -1e30f;

#define SB() do {} while (0)
template <int NQ, int D0, bool ALIBI, bool WINDOW>
DI void attn_tile(const bf16x8* qf, const LAS unsigned char* kb, const LAS unsigned char* vbuf, float& mhat, f32x16& negm, float& l, f32x16 (&o)[2], float dq, float slope2, int r32, int hi, const bool first) {
    bf16x8 kf[2][NQ];
#pragma unroll
    for (int d0 = 0; d0 < NQ; ++d0)
#pragma unroll
        for (int blk = 0; blk < 2; ++blk) kf[blk][d0] = *(const LAS bf16x8*)(kb + ((32 * blk + r32) * AT_KLD + 16 * (D0 + d0) + 8 * hi) * 2);
    SB();
    f32x16 s[2];
#pragma unroll
    for (int d0 = 0; d0 < NQ; ++d0)
#pragma unroll
        for (int blk = 0; blk < 2; ++blk) s[blk] = __builtin_amdgcn_mfma_f32_32x32x16_bf16(kf[blk][d0], qf[D0 + d0], d0 == 0 ? negm : s[blk], 0, 0, 0);
    SB();
    bf16x8 vA[2][2], vB[2][2];
#pragma unroll
    for (int kk = 0; kk < 2; ++kk)
#pragma unroll
        for (int d = 0; d < 2; ++d) {
            vA[d][kk] = *(const LAS bf16x8*)(vbuf + ((32 * d + r32) * AT_VLD + 16 * kk + 8 * hi) * 2);
        }
    if (ALIBI || WINDOW) {
#pragma unroll
        for (int blk = 0; blk < 2; ++blk)
#pragma unroll
            for (int r = 0; r < 16; ++r) {
                const float dist = fabsf(dq - (float)(32 * blk + (r & 3) + 8 * (r >> 2)));
                float v = s[blk][r];
                if (ALIBI) v = v - slope2 * dist;
                if (WINDOW) v = dist > 128.f ? NEG_BIG : v;
                s[blk][r] = v;
            }
    }
    float mx = s[0][0];
#pragma unroll
    for (int r = 1; r < 16; ++r) mx = fmaxf(mx, s[0][r]);
#pragma unroll
    for (int r = 0; r < 16; ++r) mx = fmaxf(mx, s[1][r]);
    mx = fmaxf(mx, __shfl_xor(mx, 32));
    if (first || __any(mx > 8.f)) {
        const float dl = first ? mx : fmaxf(mx, 0.f);
        mhat += dl;
#pragma unroll
        for (int blk = 0; blk < 2; ++blk)
#pragma unroll
            for (int r = 0; r < 16; ++r) s[blk][r] -= dl;
#pragma unroll
        for (int r = 0; r < 16; ++r) negm[r] = -mhat;
        const float f = first ? 1.f : __builtin_amdgcn_exp2f(-dl);
        l *= f;
#pragma unroll
        for (int d = 0; d < 2; ++d)
#pragma unroll
            for (int r = 0; r < 16; ++r) o[d][r] *= f;
    }
    float ps = 0.f;
#pragma unroll
    for (int blk = 0; blk < 2; ++blk)
#pragma unroll
        for (int r = 0; r < 16; ++r) { const float p = __builtin_amdgcn_exp2f(s[blk][r]); s[blk][r] = p; ps += p; }
    l += ps;
    bf16x8 pf[2][2];
#pragma unroll
    for (int blk = 0; blk < 2; ++blk)
#pragma unroll
        for (int kk = 0; kk < 2; ++kk) {
            u32x4 pw; pw.x = pk2(s[blk][8 * kk + 0], s[blk][8 * kk + 1]); pw.y = pk2(s[blk][8 * kk + 2], s[blk][8 * kk + 3]);
            pw.z = pk2(s[blk][8 * kk + 4], s[blk][8 * kk + 5]); pw.w = pk2(s[blk][8 * kk + 6], s[blk][8 * kk + 7]);
            pf[blk][kk] = __builtin_bit_cast(bf16x8, pw);
        }
    SB();
#pragma unroll
    for (int kk = 0; kk < 2; ++kk)
#pragma unroll
        for (int d = 0; d < 2; ++d) {
            vB[d][kk] = *(const LAS bf16x8*)(vbuf + ((32 * d + r32) * AT_VLD + 32 + 16 * kk + 8 * hi) * 2);
        }
#pragma unroll
    for (int kk = 0; kk < 2; ++kk)
#pragma unroll
        for (int d = 0; d < 2; ++d) o[d] = __builtin_amdgcn_mfma_f32_32x32x16_bf16(vA[d][kk], pf[0][kk], o[d], 0, 0, 0);
    SB();
#pragma unroll
    for (int kk = 0; kk < 2; ++kk)
#pragma unroll
        for (int d = 0; d < 2; ++d) o[d] = __builtin_amdgcn_mfma_f32_32x32x16_bf16(vB[d][kk], pf[1][kk], o[d], 0, 0, 0);
    SB();
}


template <int NQ, int D0, bool ALIBI, bool WINDOW>
DI void attn_tile_x(const bf16x8* qf, const LAS unsigned char* kb, f32x16 (&s)[2], float& mhat, f32x16& negm, float& l, f32x16 (&o)[2], float dq, float slope2, int r32, int hi, const bool first) {
    bf16x8 kf[2][NQ];
#pragma unroll
    for (int d0 = 0; d0 < NQ; ++d0)
#pragma unroll
        for (int blk = 0; blk < 2; ++blk) kf[blk][d0] = *(const LAS bf16x8*)(kb + ((32 * blk + r32) * AT_KLD + 16 * (D0 + d0) + 8 * hi) * 2);
    SB();
#pragma unroll
    for (int d0 = 0; d0 < NQ; ++d0)
#pragma unroll
        for (int blk = 0; blk < 2; ++blk) s[blk] = __builtin_amdgcn_mfma_f32_32x32x16_bf16(kf[blk][d0], qf[D0 + d0], d0 == 0 ? negm : s[blk], 0, 0, 0);
    SB();
    if (ALIBI || WINDOW) {
#pragma unroll
        for (int blk = 0; blk < 2; ++blk)
#pragma unroll
            for (int r = 0; r < 16; ++r) {
                const float dist = fabsf(dq - (float)(32 * blk + (r & 3) + 8 * (r >> 2)));
                float v = s[blk][r];
                if (ALIBI) v = v - slope2 * dist;
                if (WINDOW) v = dist > 128.f ? NEG_BIG : v;
                s[blk][r] = v;
            }
    }
    float mx = s[0][0];
#pragma unroll
    for (int r = 1; r < 16; ++r) mx = fmaxf(mx, s[0][r]);
#pragma unroll
    for (int r = 0; r < 16; ++r) mx = fmaxf(mx, s[1][r]);
    mx = fmaxf(mx, __shfl_xor(mx, 32));
    if (first || __any(mx > 8.f)) {
        const float dl = first ? mx : fmaxf(mx, 0.f);
        mhat += dl;
#pragma unroll
        for (int blk = 0; blk < 2; ++blk)
#pragma unroll
            for (int r = 0; r < 16; ++r) s[blk][r] -= dl;
#pragma unroll
        for (int r = 0; r < 16; ++r) negm[r] = -mhat;
        const float f = first ? 1.f : __builtin_amdgcn_exp2f(-dl);
        l *= f;
#pragma unroll
        for (int d = 0; d < 2; ++d)
#pragma unroll
            for (int r = 0; r < 16; ++r) o[d][r] *= f;
    }
#pragma unroll
    for (int blk = 0; blk < 2; ++blk)
#pragma unroll
        for (int r = 0; r < 16; ++r) s[blk][r] = __builtin_amdgcn_exp2f(s[blk][r]);
}
DI void attn_tile_y(const f32x16 (&s)[2], const LAS unsigned char* vbuf, float& l, f32x16 (&o)[2], int r32, int hi) {
    bf16x8 vA[2][2], vB[2][2];
#pragma unroll
    for (int kk = 0; kk < 2; ++kk)
#pragma unroll
        for (int d = 0; d < 2; ++d) vA[d][kk] = *(const LAS bf16x8*)(vbuf + ((32 * d + r32) * AT_VLD + 16 * kk + 8 * hi) * 2);
    float ps = 0.f;
#pragma unroll
    for (int blk = 0; blk < 2; ++blk)
#pragma unroll
        for (int r = 0; r < 16; ++r) ps += s[blk][r];
    l += ps;
    bf16x8 pf[2][2];
#pragma unroll
    for (int blk = 0; blk < 2; ++blk)
#pragma unroll
        for (int kk = 0; kk < 2; ++kk) {
            u32x4 pw; pw.x = pk2(s[blk][8 * kk + 0], s[blk][8 * kk + 1]); pw.y = pk2(s[blk][8 * kk + 2], s[blk][8 * kk + 3]);
            pw.z = pk2(s[blk][8 * kk + 4], s[blk][8 * kk + 5]); pw.w = pk2(s[blk][8 * kk + 6], s[blk][8 * kk + 7]);
            pf[blk][kk] = __builtin_bit_cast(bf16x8, pw);
        }
    SB();
#pragma unroll
    for (int kk = 0; kk < 2; ++kk)
#pragma unroll
        for (int d = 0; d < 2; ++d) vB[d][kk] = *(const LAS bf16x8*)(vbuf + ((32 * d + r32) * AT_VLD + 32 + 16 * kk + 8 * hi) * 2);
#pragma unroll
    for (int kk = 0; kk < 2; ++kk)
#pragma unroll
        for (int d = 0; d < 2; ++d) o[d] = __builtin_amdgcn_mfma_f32_32x32x16_bf16(vA[d][kk], pf[0][kk], o[d], 0, 0, 0);
    SB();
#pragma unroll
    for (int kk = 0; kk < 2; ++kk)
#pragma unroll
        for (int d = 0; d < 2; ++d) o[d] = __builtin_amdgcn_mfma_f32_32x32x16_bf16(vB[d][kk], pf[1][kk], o[d], 0, 0, 0);
    SB();
}

template <int D0>
DI void attn_tile_d(const bf16x8* qf, const LAS unsigned char* kb, const LAS unsigned char* vbuf, float& mhat, float& l, f32x16 (&o)[2], const f32x16& pat,
                    const bool diag, const float adj, const float adj32, float dq, float slope2, int r32, int hi, const bool first) {
    __builtin_amdgcn_sched_barrier(0);
    bf16x8 kf[2][2];
#pragma unroll
    for (int d0 = 0; d0 < 2; ++d0)
#pragma unroll
        for (int blk = 0; blk < 2; ++blk) kf[blk][d0] = *(const LAS bf16x8*)(kb + ((32 * blk + r32) * AT_KLD + 16 * (D0 + d0) + 8 * hi) * 2);
    f32x16 s[2];
    if (!diag) {
#pragma unroll
        for (int d0 = 0; d0 < 2; ++d0)
#pragma unroll
            for (int blk = 0; blk < 2; ++blk) s[blk] = __builtin_amdgcn_mfma_f32_32x32x16_bf16(kf[blk][d0], qf[D0 + d0], d0 == 0 ? pat : s[blk], 0, 0, 0);
        const float sref0 = mhat - adj, sref1 = sref0 - adj32;
#pragma unroll
        for (int r = 0; r < 16; ++r) { s[0][r] -= sref0; s[1][r] -= sref1; }
    } else {
        const f32x16 zero16 = {0.f, 0.f, 0.f, 0.f, 0.f, 0.f, 0.f, 0.f, 0.f, 0.f, 0.f, 0.f, 0.f, 0.f, 0.f, 0.f};
#pragma unroll
        for (int d0 = 0; d0 < 2; ++d0)
#pragma unroll
            for (int blk = 0; blk < 2; ++blk) s[blk] = __builtin_amdgcn_mfma_f32_32x32x16_bf16(kf[blk][d0], qf[D0 + d0], d0 == 0 ? zero16 : s[blk], 0, 0, 0);
#pragma unroll
        for (int blk = 0; blk < 2; ++blk)
#pragma unroll
            for (int r = 0; r < 16; ++r) s[blk][r] = s[blk][r] - slope2 * fabsf(dq - (float)(32 * blk + (r & 3) + 8 * (r >> 2))) - mhat;
    }
    float mx = s[0][0];
#pragma unroll
    for (int r = 1; r < 16; ++r) mx = fmaxf(mx, s[0][r]);
#pragma unroll
    for (int r = 0; r < 16; ++r) mx = fmaxf(mx, s[1][r]);
    mx = fmaxf(mx, __shfl_xor(mx, 32));
    if (first || __any(mx > 8.f)) {
        const float dl = first ? mx : fmaxf(mx, 0.f);
        mhat += dl;
#pragma unroll
        for (int blk = 0; blk < 2; ++blk)
#pragma unroll
            for (int r = 0; r < 16; ++r) s[blk][r] -= dl;
        const float f = first ? 1.f : __builtin_amdgcn_exp2f(-dl);
        l *= f;
#pragma unroll
        for (int d = 0; d < 2; ++d)
#pragma unroll
            for (int r = 0; r < 16; ++r) o[d][r] *= f;
    }
    float ps = 0.f;
#pragma unroll
    for (int blk = 0; blk < 2; ++blk)
#pragma unroll
        for (int r = 0; r < 16; ++r) { const float p = __builtin_amdgcn_exp2f(s[blk][r]); s[blk][r] = p; ps += p; }
    l += ps;
    bf16x8 pf[2][2];
#pragma unroll
    for (int blk = 0; blk < 2; ++blk)
#pragma unroll
        for (int kk = 0; kk < 2; ++kk) {
            u32x4 pw; pw.x = pk2(s[blk][8 * kk + 0], s[blk][8 * kk + 1]); pw.y = pk2(s[blk][8 * kk + 2], s[blk][8 * kk + 3]);
            pw.z = pk2(s[blk][8 * kk + 4], s[blk][8 * kk + 5]); pw.w = pk2(s[blk][8 * kk + 6], s[blk][8 * kk + 7]);
            pf[blk][kk] = __builtin_bit_cast(bf16x8, pw);
        }
    bf16x8 vA[2][2], vB[2][2];
#pragma unroll
    for (int kk = 0; kk < 2; ++kk)
#pragma unroll
        for (int d = 0; d < 2; ++d) vA[d][kk] = *(const LAS bf16x8*)(vbuf + ((32 * d + r32) * AT_VLD + 16 * kk + 8 * hi) * 2);
#pragma unroll
    for (int kk = 0; kk < 2; ++kk)
#pragma unroll
        for (int d = 0; d < 2; ++d) vB[d][kk] = *(const LAS bf16x8*)(vbuf + ((32 * d + r32) * AT_VLD + 32 + 16 * kk + 8 * hi) * 2);
#pragma unroll
    for (int kk = 0; kk < 2; ++kk)
#pragma unroll
        for (int d = 0; d < 2; ++d) o[d] = __builtin_amdgcn_mfma_f32_32x32x16_bf16(vA[d][kk], pf[0][kk], o[d], 0, 0, 0);
#pragma unroll
    for (int kk = 0; kk < 2; ++kk)
#pragma unroll
        for (int d = 0; d < 2; ++d) o[d] = __builtin_amdgcn_mfma_f32_32x32x16_bf16(vB[d][kk], pf[1][kk], o[d], 0, 0, 0);
}

template <int MODE>
DI void attn_unit(const AttnArgs& a, unsigned char* smem_, int tid) {
    LAS unsigned char* smem = (LAS unsigned char*)smem_;
    constexpr int NQF = (MODE == 1) ? 6 : 4;
    constexpr bool DIST2 = false;
    const int lane = tid & 63, w = __builtin_amdgcn_readfirstlane(tid >> 6), r32 = lane & 31, hi = lane >> 5;
    constexpr bool SPLIT = false;
    const int grp = w >> 2;
    const int qw = a.q0 + 32 * w;
    const long qrow = a.row0 + qw + r32;
    bf16x8 qf[NQF];
#pragma unroll
    for (int d0 = 0; d0 < NQF; ++d0) qf[d0] = *(const GAS bf16x8*)(gptr(a.Q) + qrow * a.ldq + 16 * d0 + 8 * hi);
    int tb = 0, te = a.S / 64;
    if (MODE == 0) { const int lo = a.q0 - 128, hi_ = a.q0 + 384; tb = (lo < 0 ? 0 : lo) / 64; te = (hi_ > a.S ? a.S : hi_) / 64; }
    const int kkey = tid >> 3, kch = tid & 7;
    const GAS bf16_t* kp = gptr(a.K) + (a.row0 + kkey) * (long)a.ldk + kch * 8;
    const GAS bf16_t* k2p = gptr(a.K2) + (a.row0 + (tid >> 2)) * (long)a.ldk2 + (tid & 3) * 8;
    const GAS bf16_t* vp = gptr(a.VT) + (long)(tid >> 3) * MTOK + a.row0 + (tid & 7) * 8;
    const int kdst = (kkey * AT_KLD + kch * 8) * 2, k2dst = ((tid >> 2) * AT_KLD + 64 + (tid & 3) * 8) * 2, vdst = ((tid >> 3) * AT_VLD + 16 * ((tid & 7) >> 1) + 4 * (tid & 1)) * 2;
    u32x4 kr, k2r, vr;
    kr = *(const GAS u32x4*)(kp + (long)tb * 64 * a.ldk);
    if (MODE == 1 && tid < 256) k2r = *(const GAS u32x4*)(k2p + (long)tb * 64 * a.ldk2);
    vr = *(const GAS u32x4*)(vp + tb * 64);
    *(LAS u32x4*)(smem + kdst) = kr;
    if (MODE == 1 && tid < 256) *(LAS u32x4*)(smem + k2dst) = k2r;
    *(LAS u32x2*)(smem + AT_VOFF + vdst) = (u32x2){vr.x, vr.y}; *(LAS u32x2*)(smem + AT_VOFF + vdst + 16) = (u32x2){vr.z, vr.w};
    if (DIST2 && tb + 1 < te) {
        kr = *(const GAS u32x4*)(kp + (long)(tb + 1) * 64 * a.ldk);
        if (MODE == 1 && tid < 256) k2r = *(const GAS u32x4*)(k2p + (long)(tb + 1) * 64 * a.ldk2);
        vr = *(const GAS u32x4*)(vp + (tb + 1) * 64);
    }
    __syncthreads();
    float m0 = 0.f, l0 = 0.f, m1 = 0.f, l1 = 0.f;
    if (MODE == 0) { m0 = a.sink2; l0 = hi == 0 ? 1.f : 0.f; }
    f32x16 o0[2], o1[2], ng0, ng1, pat;
#pragma unroll
    for (int r = 0; r < 16; ++r) { ng0[r] = -m0; ng1[r] = 0.f; }
    bool flipped = false;
    if (MODE == 3) {
#pragma unroll
        for (int r = 0; r < 16; ++r) pat[r] = a.slope2 * (float)((r & 3) + 8 * (r >> 2));
    }
#pragma unroll
    for (int d = 0; d < 2; ++d)
#pragma unroll
        for (int r = 0; r < 16; ++r) { o0[d][r] = 0.f; o1[d][r] = 0.f; }
    auto step = [&](const int t, u32x4& xk, u32x4& xk2, u32x4& xv, u32x4& yk, u32x4& yk2, u32x4& yv) __attribute__((always_inline)) {
        const int cur = (t - tb) & 1;
        const bool more = (t + 1 < te);
        const bool more2 = (t + 2 < te);
        if (DIST2 ? more2 : more) {
            const int tl = t + (DIST2 ? 2 : 1);
            yk = *(const GAS u32x4*)(kp + (long)tl * 64 * a.ldk);
            if (MODE == 1 && tid < 256) yk2 = *(const GAS u32x4*)(k2p + (long)tl * 64 * a.ldk2);
            yv = *(const GAS u32x4*)(vp + tl * 64);
        }
        const LAS unsigned char* kb = smem + cur * AT_KBUF;
        const LAS unsigned char* vb = smem + AT_VOFF + cur * AT_VBUF;
        const int k0 = t * 64;
        bool active = true;
        if (MODE == 0) active = (k0 + 63 >= qw - 128) && (k0 <= qw + 31 + 128);
        if (SPLIT) {
            f32x16 sp[2];
            if (active) {
                const float dq = (float)(qw + r32 - k0 - 4 * hi);
                const bool first = (MODE != 0) && (t == tb);
                if (MODE == 0) attn_tile_x<4, 0, true, true>(qf, kb, sp, m0, ng0, l0, o0, dq, a.slope2, r32, hi, first);
                else if (MODE == 1) attn_tile_x<6, 0, false, false>(qf, kb, sp, m0, ng0, l0, o0, dq, a.slope2, r32, hi, first);
                else attn_tile_x<4, 0, false, false>(qf, kb, sp, m0, ng0, l0, o0, dq, a.slope2, r32, hi, first);
            }
            if (grp == 1 && more) {
                LAS unsigned char* nb = smem + (cur ^ 1) * AT_KBUF;
                *(LAS u32x4*)(nb + kdst) = xk;
                if (MODE == 1 && tid < 256) *(LAS u32x4*)(nb + k2dst) = xk2;
                *(LAS u32x2*)(smem + AT_VOFF + (cur ^ 1) * AT_VBUF + vdst) = (u32x2){xv.x, xv.y}; *(LAS u32x2*)(smem + AT_VOFF + (cur ^ 1) * AT_VBUF + vdst + 16) = (u32x2){xv.z, xv.w};
            }
            asm volatile("s_waitcnt lgkmcnt(0)" ::: "memory"); __builtin_amdgcn_s_barrier(); asm volatile("" ::: "memory");
            if (active) attn_tile_y(sp, vb, l0, o0, r32, hi);
            if (grp == 0 && more) {
                LAS unsigned char* nb = smem + (cur ^ 1) * AT_KBUF;
                *(LAS u32x4*)(nb + kdst) = xk;
                if (MODE == 1 && tid < 256) *(LAS u32x4*)(nb + k2dst) = xk2;
                *(LAS u32x2*)(smem + AT_VOFF + (cur ^ 1) * AT_VBUF + vdst) = (u32x2){xv.x, xv.y}; *(LAS u32x2*)(smem + AT_VOFF + (cur ^ 1) * AT_VBUF + vdst + 16) = (u32x2){xv.z, xv.w};
            }
            asm volatile("s_waitcnt lgkmcnt(0)" ::: "memory"); __builtin_amdgcn_s_barrier(); asm volatile("" ::: "memory");
            return;
        }
        if (active) {
            const float dq = (float)(qw + r32 - k0 - 4 * hi);
            const bool first = (MODE != 0) && (t == tb);
            if (MODE == 0) attn_tile<4, 0, true, true>(qf, kb, vb, m0, ng0, l0, o0, dq, a.slope2, r32, hi, first);
            else if (MODE == 1) attn_tile<6, 0, false, false>(qf, kb, vb, m0, ng0, l0, o0, dq, a.slope2, r32, hi, first);
            else if (MODE == 2) attn_tile<4, 0, false, false>(qf, kb, vb, m0, ng0, l0, o0, dq, a.slope2, r32, hi, first);
            else {
                const bool right = (k0 > qw + 31), diag = !right && !(k0 + 63 < qw);
                if (right && !flipped) {
#pragma unroll
                    for (int r = 0; r < 16; ++r) { pat[r] = -pat[r]; asm volatile("" : "+v"(pat[r])); }
                    flipped = true;
                }
                const float adj = right ? a.slope2 * dq : -a.slope2 * dq;
                const float adj32 = right ? -32.f * a.slope2 : 32.f * a.slope2;
                attn_tile_d<0>(qf, kb, vb, m0, l0, o0, pat, diag, adj, adj32, dq, a.slope2, r32, hi, first);
                __builtin_amdgcn_sched_barrier(0);
                float dq1 = dq; asm volatile("" : "+v"(dq1));
                attn_tile_d<2>(qf, kb, vb, m1, l1, o1, pat, diag, adj, adj32, dq1, a.slope2, r32, hi, first);
            }
        }
        if (more) {
            LAS unsigned char* nb = smem + (cur ^ 1) * AT_KBUF;
            *(LAS u32x4*)(nb + kdst) = xk;
            if (MODE == 1 && tid < 256) *(LAS u32x4*)(nb + k2dst) = xk2;
            *(LAS u32x2*)(smem + AT_VOFF + (cur ^ 1) * AT_VBUF + vdst) = (u32x2){xv.x, xv.y}; *(LAS u32x2*)(smem + AT_VOFF + (cur ^ 1) * AT_VBUF + vdst + 16) = (u32x2){xv.z, xv.w};
        }
        asm volatile("s_waitcnt lgkmcnt(0)" ::: "memory"); __builtin_amdgcn_s_barrier(); asm volatile("" ::: "memory");
    };
    u32x4 kn, k2n, vn;
    if (SPLIT && grp == 1) { __builtin_amdgcn_s_barrier(); asm volatile("" ::: "memory"); }
    if (DIST2) {
        for (int t = tb; t < te; t += 2) {
            step(t, kr, k2r, vr, kn, k2n, vn);
            if (t + 1 < te) step(t + 1, kn, k2n, vn, kr, k2r, vr);
        }
    } else {
        for (int t = tb; t < te; ++t) step(t, kr, k2r, vr, kr, k2r, vr);
    }
    if (SPLIT && grp == 0) { __builtin_amdgcn_s_barrier(); asm volatile("" ::: "memory"); }
    l0 += __shfl_xor(l0, 32);
    const float i0 = 1.f / l0;
    GAS bf16_t* op = gptr(a.O) + qrow * DMODEL;
    if (MODE != 3) {
#pragma unroll
        for (int d = 0; d < 2; ++d)
#pragma unroll
            for (int g4 = 0; g4 < 4; ++g4) {
                u32x2 wv; wv.x = pk2(o0[d][4 * g4] * i0, o0[d][4 * g4 + 1] * i0); wv.y = pk2(o0[d][4 * g4 + 2] * i0, o0[d][4 * g4 + 3] * i0);
                *(GAS u32x2*)(op + 32 * d + 8 * g4 + 4 * hi) = wv;
            }
    } else {
        l1 += __shfl_xor(l1, 32);
        const float i1 = a.lam / l1;
        float ss = 0.f;
#pragma unroll
        for (int d = 0; d < 2; ++d)
#pragma unroll
            for (int r = 0; r < 16; ++r) { const float v = o0[d][r] * i0 - o1[d][r] * i1; o0[d][r] = v; ss += v * v; }
        ss += __shfl_xor(ss, 32);
        const float rn = rsqrtf(ss * (1.f / 64.f) + EPS) * a.post;
#pragma unroll
        for (int d = 0; d < 2; ++d)
#pragma unroll
            for (int g4 = 0; g4 < 4; ++g4) {
                const int dd = 32 * d + 8 * g4 + 4 * hi;
                const f32x4 gn = *(const GAS f32x4*)(gptr(a.subn) + dd);
                u32x2 wv; wv.x = pk2(o0[d][4 * g4] * rn * gn[0], o0[d][4 * g4 + 1] * rn * gn[1]); wv.y = pk2(o0[d][4 * g4 + 2] * rn * gn[2], o0[d][4 * g4 + 3] * rn * gn[3]);
                *(GAS u32x2*)(op + dd) = wv;
            }
    }
}

DI void attn_pair_sm(f32x16 (&s)[2], float& mhat, float& l, f32x16 (&o)[2], bf16x8 (&pf)[2][2], const bool first) {
    float mx = s[0][0];
#pragma unroll
    for (int r = 1; r < 16; ++r) mx = fmaxf(mx, s[0][r]);
#pragma unroll
    for (int r = 0; r < 16; ++r) mx = fmaxf(mx, s[1][r]);
    mx = fmaxf(mx, __shfl_xor(mx, 32)) - mhat;
    if (first || __any(mx > 8.f)) {
        const float dl = first ? mx : fmaxf(mx, 0.f);
        mhat += dl;
        const float f = first ? 1.f : __builtin_amdgcn_exp2f(-dl);
        l *= f;
#pragma unroll
        for (int d = 0; d < 2; ++d)
#pragma unroll
            for (int r = 0; r < 16; ++r) o[d][r] *= f;
    }
    float ps = 0.f;
#pragma unroll
    for (int blk = 0; blk < 2; ++blk)
#pragma unroll
        for (int r = 0; r < 16; ++r) { const float p = __builtin_amdgcn_exp2f(s[blk][r] - mhat); s[blk][r] = p; ps += p; }
    l += ps;
#pragma unroll
    for (int blk = 0; blk < 2; ++blk)
#pragma unroll
        for (int kk = 0; kk < 2; ++kk) {
            u32x4 pw; pw.x = pk2(s[blk][8 * kk + 0], s[blk][8 * kk + 1]); pw.y = pk2(s[blk][8 * kk + 2], s[blk][8 * kk + 3]);
            pw.z = pk2(s[blk][8 * kk + 4], s[blk][8 * kk + 5]); pw.w = pk2(s[blk][8 * kk + 6], s[blk][8 * kk + 7]);
            pf[blk][kk] = __builtin_bit_cast(bf16x8, pw);
        }
}
DI void attn_unit_pairC(const AttnArgs& a, unsigned char* smem_, int tid) {
    LAS unsigned char* smem = (LAS unsigned char*)smem_;
    const int lane = tid & 63, w = __builtin_amdgcn_readfirstlane(tid >> 6), r32 = lane & 31, hi = lane >> 5;
    const int qw = a.q0 + 32 * w;
    const long qrow = a.row0 + qw + r32;
    bf16x8 qfA[4], qfB[4];
#pragma unroll
    for (int d0 = 0; d0 < 4; ++d0) { qfA[d0] = *(const GAS bf16x8*)(gptr(a.Q) + qrow * a.ldq + 16 * d0 + 8 * hi); qfB[d0] = *(const GAS bf16x8*)(gptr(a.Q) + qrow * a.ldq + 64 + 16 * d0 + 8 * hi); }
    const int tb = 0, te = a.S / 64;
    const int kkey = tid >> 3, kch = tid & 7;
    const GAS bf16_t* kp = gptr(a.K) + (a.row0 + kkey) * (long)a.ldk + kch * 8;
    const GAS bf16_t* vp = gptr(a.VT) + (long)(tid >> 3) * MTOK + a.row0 + (tid & 7) * 8;
    const int kdst = (kkey * AT_KLD + kch * 8) * 2, vdst = ((tid >> 3) * AT_VLD + 16 * ((tid & 7) >> 1) + 4 * (tid & 1)) * 2;
    u32x4 kr, vr;
    kr = *(const GAS u32x4*)(kp + (long)tb * 64 * a.ldk);
    vr = *(const GAS u32x4*)(vp + tb * 64);
    *(LAS u32x4*)(smem + kdst) = kr;
    *(LAS u32x2*)(smem + AT_VOFF + vdst) = (u32x2){vr.x, vr.y}; *(LAS u32x2*)(smem + AT_VOFF + vdst + 16) = (u32x2){vr.z, vr.w};
    __syncthreads();
    float mA = 0.f, lA = 0.f, mB = 0.f, lB = 0.f;
    f32x16 oA[2], oB[2];
#pragma unroll
    for (int d = 0; d < 2; ++d)
#pragma unroll
        for (int r = 0; r < 16; ++r) { oA[d][r] = 0.f; oB[d][r] = 0.f; }
    const f32x16 zero16 = {0.f, 0.f, 0.f, 0.f, 0.f, 0.f, 0.f, 0.f, 0.f, 0.f, 0.f, 0.f, 0.f, 0.f, 0.f, 0.f};
    for (int t = tb; t < te; ++t) {
        const int cur = (t - tb) & 1;
        const bool more = (t + 1 < te);
        if (more) { kr = *(const GAS u32x4*)(kp + (long)(t + 1) * 64 * a.ldk); vr = *(const GAS u32x4*)(vp + (t + 1) * 64); }
        const LAS unsigned char* kb = smem + cur * AT_KBUF;
        const LAS unsigned char* vb = smem + AT_VOFF + cur * AT_VBUF;
        const bool first = (t == tb);
        f32x16 sA[2], sB[2];
        {
            bf16x8 kf[2][4];
#pragma unroll
            for (int d0 = 0; d0 < 4; ++d0)
#pragma unroll
                for (int blk = 0; blk < 2; ++blk) kf[blk][d0] = *(const LAS bf16x8*)(kb + ((32 * blk + r32) * AT_KLD + 16 * d0 + 8 * hi) * 2);
#pragma unroll
            for (int d0 = 0; d0 < 4; ++d0)
#pragma unroll
                for (int blk = 0; blk < 2; ++blk) {
                    sA[blk] = __builtin_amdgcn_mfma_f32_32x32x16_bf16(kf[blk][d0], qfA[d0], d0 == 0 ? zero16 : sA[blk], 0, 0, 0);
                    sB[blk] = __builtin_amdgcn_mfma_f32_32x32x16_bf16(kf[blk][d0], qfB[d0], d0 == 0 ? zero16 : sB[blk], 0, 0, 0);
                }
        }
        bf16x8 pfA[2][2], pfB[2][2];
        attn_pair_sm(sA, mA, lA, oA, pfA, first);
        attn_pair_sm(sB, mB, lB, oB, pfB, first);
#pragma unroll
        for (int blk = 0; blk < 2; ++blk) {
            bf16x8 vf[2][2];
#pragma unroll
            for (int kk = 0; kk < 2; ++kk)
#pragma unroll
                for (int d = 0; d < 2; ++d) vf[kk][d] = *(const LAS bf16x8*)(vb + ((32 * d + r32) * AT_VLD + 32 * blk + 16 * kk + 8 * hi) * 2);
#pragma unroll
            for (int kk = 0; kk < 2; ++kk)
#pragma unroll
                for (int d = 0; d < 2; ++d) {
                    oA[d] = __builtin_amdgcn_mfma_f32_32x32x16_bf16(vf[kk][d], pfA[blk][kk], oA[d], 0, 0, 0);
                    oB[d] = __builtin_amdgcn_mfma_f32_32x32x16_bf16(vf[kk][d], pfB[blk][kk], oB[d], 0, 0, 0);
                }
        }
        if (more) {
            LAS unsigned char* nb = smem + (cur ^ 1) * AT_KBUF;
            *(LAS u32x4*)(nb + kdst) = kr;
            *(LAS u32x2*)(smem + AT_VOFF + (cur ^ 1) * AT_VBUF + vdst) = (u32x2){vr.x, vr.y}; *(LAS u32x2*)(smem + AT_VOFF + (cur ^ 1) * AT_VBUF + vdst + 16) = (u32x2){vr.z, vr.w};
        }
        asm volatile("s_waitcnt lgkmcnt(0)" ::: "memory"); __builtin_amdgcn_s_barrier(); asm volatile("" ::: "memory");
    }
    lA += __shfl_xor(lA, 32); lB += __shfl_xor(lB, 32);
    const float iA = 1.f / lA, iB = 1.f / lB;
    GAS bf16_t* op = gptr(a.O) + qrow * DMODEL;
#pragma unroll
    for (int d = 0; d < 2; ++d)
#pragma unroll
        for (int g4 = 0; g4 < 4; ++g4) {
            u32x2 wa, wb;
            wa.x = pk2(oA[d][4 * g4] * iA, oA[d][4 * g4 + 1] * iA); wa.y = pk2(oA[d][4 * g4 + 2] * iA, oA[d][4 * g4 + 3] * iA);
            wb.x = pk2(oB[d][4 * g4] * iB, oB[d][4 * g4 + 1] * iB); wb.y = pk2(oB[d][4 * g4 + 2] * iB, oB[d][4 * g4 + 3] * iB);
            *(GAS u32x2*)(op + 32 * d + 8 * g4 + 4 * hi) = wa;
            *(GAS u32x2*)(op + 64 + 32 * d + 8 * g4 + 4 * hi) = wb;
        }
}

template <class ColMap, class Scale>
DI void wprep(const float* __restrict__ src, int ldsrc, int K, bf16_t* dst, int ndst, const float* __restrict__ gain, ColMap cm, Scale sc, LAS float* scr, int gw, int ngw, int lane, int& ibase) {
    const int nblk = ndst / 32, nitems = (K / 64) * nblk;
    const int first = (gw + ngw - (ibase % ngw)) % ngw;
    ibase += nitems;
    for (int it = first; it < nitems; it += ngw) {
        const int kb = it / nblk, nb = it - kb * nblk, k0 = 64 * kb, n0 = 32 * nb;
        const int c = cm(n0 + (lane & 31)); const float sv = sc(n0 + (lane & 31));
        float wv[32];
#pragma unroll
        for (int i = 0; i < 32; ++i) { const int k = k0 + 2 * i + (lane >> 5); wv[i] = c >= 0 ? src[(long)k * ldsrc + c] : 0.f; }
#pragma unroll
        for (int i = 0; i < 32; ++i) {
            const int kk = 2 * i + (lane >> 5), k = k0 + kk;
            scr[kk * 33 + (lane & 31)] = wv[i] * (gain ? gain[k] : 1.f) * sv;
        }
        const int c8 = lane & 7;
#pragma unroll
        for (int j = 0; j < 4; ++j) {
            const int n = (lane >> 3) + 8 * j; const LAS float* q = scr + (8 * c8) * 33 + n;
            u32x4 o; o.x = pk2(q[0], q[33]); o.y = pk2(q[2 * 33], q[3 * 33]); o.z = pk2(q[4 * 33], q[5 * 33]); o.w = pk2(q[6 * 33], q[7 * 33]);
            *(u32x4*)(dst + (long)(n0 + n) * K + k0 + 8 * c8) = o;
        }
        asm volatile("s_waitcnt lgkmcnt(0)" ::: "memory");
    }
}

DI int in_colmap(int n) {
    if (n < 256) return n;
    if (n < 384) return 256 + (n - 256);
    if (n < 512) return 1184 + (n - 384);
    if (n < 768) return 512 + (n - 512);
    if (n < 896) return 768 + (n - 768);
    if (n < 928) return 896 + (n - 896);
    if (n < 1024) return -1;
    if (n < 1280) return 928 + (n - 1024);
    if (n < 1536) return 1440 + (n - 1280);
    if (n < 1792) return 1696 + (n - 1536);
    if (n < 1920) return 384 + (n - 1792);
    if (n < 2048) return 1312 + (n - 1920);
    return 1952 + (n - 2048);
}

DI const float* inptr(const Params& p, int i) { asm volatile("" : "+s"(i)); return p.in[i]; }
#define XB_TMO      128
#define XB_XCNT(j)  (256  + 64 * (j))
#define XB_XSUB(j)  (1280 + 64 * (j))
#define XB_XGEN(j)  (2304 + 64 * (j))
#define XB_TOP      3328
#define XB_TOPGEN   3392
#define XCD_BAR_WORDS 3456
#define XB_SPIN_CAP (1u << 18)

__device__ __forceinline__ unsigned xb_ld(unsigned* p)              { return __hip_atomic_load(p, __ATOMIC_RELAXED, __HIP_MEMORY_SCOPE_AGENT); }
__device__ __forceinline__ unsigned xb_add(unsigned* p, unsigned v) { return __hip_atomic_fetch_add(p, v, __ATOMIC_RELAXED, __HIP_MEMORY_SCOPE_AGENT); }
__device__ __forceinline__ unsigned xb_xcc_id() { return (unsigned)__builtin_amdgcn_s_getreg((3 << 11) | 20) & 0xFu; }
#define XB_SPIN(cond, bar) do { unsigned _sp = 0; while (cond) { __builtin_amdgcn_s_sleep(1); \
    if ((++_sp & 255u) == 0u) { if (xb_ld(&(bar)[XB_TMO])) break; if (_sp > XB_SPIN_CAP) { atomicAdd(&(bar)[XB_TMO], 1u); break; } } } } while (0)

struct XcdBarrier {
    unsigned* bar; unsigned x;
    volatile LAS unsigned* st;
};

__device__ __forceinline__ XcdBarrier xcd_barrier_post(unsigned* bar, volatile LAS unsigned* st, int wid) {
    XcdBarrier b; b.bar = bar; b.x = xb_xcc_id(); b.st = st;
    if (wid == 0 && lane_id() == 0) (void)xb_add(&bar[XB_XCNT(b.x)], 1u);
    return b;
}
__device__ __forceinline__ void xcd_barrier_complete(unsigned* bar, unsigned x, unsigned& nloc, unsigned& nx) {
    const unsigned G = gridDim.x * gridDim.y * gridDim.z;
    unsigned sum, cnt, mine, sp = 0u;
    for (;;) {
        sum = 0u; cnt = 0u; mine = 0u;
#pragma unroll
        for (unsigned j = 0; j < 16; ++j) { const unsigned c = xb_ld(&bar[XB_XCNT(j)]); sum += c; cnt += (c > 0u) ? 1u : 0u; mine = (j == x) ? c : mine; }
        if (sum == G) break;
        __builtin_amdgcn_s_sleep(1);
        if ((++sp & 255u) == 0u) { if (xb_ld(&bar[XB_TMO])) break; if (sp > XB_SPIN_CAP) { atomicAdd(&bar[XB_TMO], 1u); break; } }
    }
    nloc = mine > 0u ? mine : 1u; nx = cnt > 0u ? cnt : 1u;
}

__device__ __forceinline__ void xcd_barrier(const XcdBarrier& b, int wid) {
    asm volatile("s_waitcnt vmcnt(0)" ::: "memory");
    __syncthreads();
    if (wid == 0 && lane_id() == 0) {
        unsigned* bar = b.bar;
        __builtin_amdgcn_s_waitcnt(0);
        unsigned nloc = b.st[0], nx = b.st[1];
        if (nloc == 0u) { xcd_barrier_complete(bar, b.x, nloc, nx); b.st[0] = nloc; b.st[1] = nx; }
        const unsigned old = xb_add(&bar[XB_XSUB(b.x)], 1u);
        const unsigned gen = old / nloc;
        if (old + 1u == (gen + 1u) * nloc) {
            __builtin_amdgcn_fence(__ATOMIC_RELEASE, "agent");
            asm volatile("s_waitcnt vmcnt(0)" ::: "memory");
            const unsigned og = xb_add(&bar[XB_TOP], 1u);
            const unsigned tg = og / nx;
            if (og + 1u == (tg + 1u) * nx) xb_add(&bar[XB_TOPGEN], 1u);
            else XB_SPIN(xb_ld(&bar[XB_TOPGEN]) == tg, bar);
            __builtin_amdgcn_fence(__ATOMIC_ACQUIRE, "agent");
            xb_add(&bar[XB_XGEN(b.x)], 1u);
            asm volatile("s_waitcnt vmcnt(0)" ::: "memory");
        } else {
            XB_SPIN(xb_ld(&bar[XB_XGEN(b.x)]) == gen, bar);
            __builtin_amdgcn_fence(__ATOMIC_ACQUIRE, "agent");
            asm volatile("s_waitcnt vmcnt(0)" ::: "memory");
        }
    }
    __syncthreads();
}
DI void grid_barrier(unsigned* ctr, unsigned target, int wid) {
    __threadfence();
    __syncthreads();
    if (wid == 0 && lane_id() == 0) {
        __hip_atomic_fetch_add(ctr, 1u, __ATOMIC_RELEASE, __HIP_MEMORY_SCOPE_AGENT);
        unsigned spins = 0;
        while (__hip_atomic_load(ctr, __ATOMIC_ACQUIRE, __HIP_MEMORY_SCOPE_AGENT) < target) { __builtin_amdgcn_s_sleep(4); if (++spins > (1u << 24)) break; }
    }
    __syncthreads();
    __threadfence();
}

template <int PH>
DI void run_phase(const Params& p, const int wid, unsigned char* smem) {
    constexpr int ph = PH;
    const int wr = wid >> 2, wc = wid & 3;
    const int nblk = gridDim.x, bid = blockIdx.x;
    const long gthreads = (long)nblk * NTHREADS;
    const int gw = bid * 8 + wid, ngw = nblk * 8;
        const int lane = lane_id(), tid = wid * 64 + lane;
        unsigned char* ws = p.ws; asm volatile("" : "+s"(ws));
            float* pout = p.out; asm volatile("" : "+s"(pout));
        unsigned* ctl = (unsigned*)(ws + WS_CTL);
        float* stat = (float*)(ws + WS_STAT);
        float* rope = (float*)(ws + WS_ROPE);
        bf16_t* H = (bf16_t*)(ws + WS_H); bf16_t* VT = (bf16_t*)(ws + WS_VT); bf16_t* Gb = (bf16_t*)(ws + WS_G);
        bf16_t* XB = (bf16_t*)(ws + WS_XB); bf16_t* QB = (bf16_t*)(ws + WS_QB); bf16_t* KBN = (bf16_t*)(ws + WS_KBN); bf16_t* ATT = (bf16_t*)(ws + WS_ATT);
        const long gtid = (long)bid * NTHREADS + tid;
        if (ph == 0 && (SUBMASK & 0x100)) {
            for (long i = gtid; i < 5L * MTOK; i += gthreads) stat[MTOK + i] = 0.f;
            for (long i = gtid; i < 4096L * 16; i += gthreads) {
                const int pos = (int)(i >> 4), k = (int)(i & 15);
                const float inv = exp2f(-(float)k * (13.287712379549449f / 16.f));
                float sn, cs; sincosf((float)pos * inv, &sn, &cs);
                rope[2 * i] = cs; rope[2 * i + 1] = sn;
            }
            {
                const float* xin0 = inptr(p, 0); const float* xin1 = inptr(p, 1);
                for (int row0 = gw; row0 < MTOK; row0 += 4 * ngw) {
                    f32x4 va[4][4];
#pragma unroll
                    for (int q = 0; q < 4; ++q) {
                        const int row = row0 + q * ngw;
                        if (row < MTOK) {
                            const GAS float* xr = row < MPROMPT ? gptr(xin0) + (long)row * DMODEL : gptr(xin1) + (long)(row - MPROMPT) * DMODEL;
#pragma unroll
                            for (int j = 0; j < 2; ++j) { va[q][2 * j] = *(const GAS f32x4*)(xr + 512 * j + 8 * lane); va[q][2 * j + 1] = *(const GAS f32x4*)(xr + 512 * j + 8 * lane + 4); }
                        }
                    }
#pragma unroll
                    for (int q = 0; q < 4; ++q) {
                        const int row = row0 + q * ngw;
                        if (row < MTOK) {
                            float ss = 0.f;
#pragma unroll
                            for (int j = 0; j < 2; ++j) {
                                const f32x4 a = va[q][2 * j], b = va[q][2 * j + 1];
                                ss += (a[0] * a[0] + a[1] * a[1]) + (a[2] * a[2] + a[3] * a[3]) + (b[0] * b[0] + b[1] * b[1]) + (b[2] * b[2] + b[3] * b[3]);
                                u32x4 w; w.x = pk2(a[0], a[1]); w.y = pk2(a[2], a[3]); w.z = pk2(b[0], b[1]); w.w = pk2(b[2], b[3]);
                                *(GAS u32x4*)(gptr(XB) + (long)row * DMODEL + 512 * j + 8 * lane) = w;
                            }
#pragma unroll
                            for (int o = 1; o < 64; o <<= 1) ss += __shfl_xor(ss, o);
                            if (lane == 0) stat[ST_ATTN0 * MTOK + row] = ss;
                        }
                    }
                }
            }
            LAS float* scr = (LAS float*)((LAS unsigned char*)smem + wid * 8448);
            int ibase = 0;
            for (int l = 0; l < 2; ++l) {
                unsigned char* wl = ws + WS_W + l * WL_STRIDE;
                wprep(inptr(p, 3) + (long)l * DMODEL * INW, INW, DMODEL, (bf16_t*)(wl + WL_IN), 2304, inptr(p, 2) + l * DMODEL, [](int n) { return in_colmap(n); },
                      [](int n) { return n < 256 ? 0.125f * LOG2E : ((n >= 1280 && n < 1536) ? 0.17677669529663687f * LOG2E : 1.f); }, scr, gw, ngw, lane, ibase);
                wprep(inptr(p, 6) + (long)l * 256 * 384, 384, 256, (bf16_t*)(wl + WL_QUP), 512, inptr(p, 5) + l * 256,
                      [](int s) { if (s >= 384) return -1; const int h = s / 96, w = s % 96; if (w < 64) return h * 96 + w; const int g = (w - 64) >> 3, e = (w - 64) & 7; return h * 96 + 64 + (e < 4 ? 4 * g + e : 16 + 4 * g + (e - 4)); },
                      [](int) { return 0.10206207261596575f * LOG2E; }, scr, gw, ngw, lane, ibase);
                wprep(inptr(p, 8) + (long)l * 128 * 512, 512, 128, (bf16_t*)(wl + WL_KUP), 256, inptr(p, 7) + l * 128, [](int n) { return (n >> 6) * 128 + (n & 63); }, [](int) { return 1.f; }, scr, gw, ngw, lane, ibase);
                wprep(inptr(p, 8) + (long)l * 128 * 512, 512, 128, (bf16_t*)(wl + WL_VUP), 256, inptr(p, 7) + l * 128, [](int n) { return (n >> 6) * 128 + 64 + (n & 63); }, [](int) { return 1.f; }, scr, gw, ngw, lane, ibase);
                wprep(inptr(p, 16) + (long)l * DMODEL * DMODEL, DMODEL, DMODEL, (bf16_t*)(wl + WL_OUT), 1024, nullptr, [](int n) { return n; }, [](int) { return 1.f; }, scr, gw, ngw, lane, ibase);
                wprep(inptr(p, 18) + (long)l * DMODEL * DFF2, DFF2, DMODEL, (bf16_t*)(wl + WL_UP), DFF2, inptr(p, 17) + l * DMODEL,
                      [](int n) { const int pn = n >> 8, r = n & 255; return (r >> 7) * DFF + 128 * pn + (r & 127); }, [](int) { return 1.f; }, scr, gw, ngw, lane, ibase);
                wprep(inptr(p, 22) + (long)l * DFF * DMODEL, DMODEL, DFF, (bf16_t*)(wl + WL_DOWN), 1024, nullptr, [](int n) { return n; }, [](int) { return 1.f; }, scr, gw, ngw, lane, ibase);
            }
            for (long i = gtid; i < 2L * DFF; i += gthreads) {
                const int l = (int)(i / DFF), ff = (int)(i % DFF);
                const float* cw = inptr(p, 20) + (long)l * 3 * DFF2; const float* cb = inptr(p, 21) + (long)l * DFF2;
                float* o = (float*)(ws + WS_CP) + i * 8;
                o[0] = cw[ff]; o[1] = cw[DFF2 + ff]; o[2] = cw[2 * DFF2 + ff]; o[3] = cb[ff];
                o[4] = cw[DFF + ff]; o[5] = cw[DFF2 + DFF + ff]; o[6] = cw[2 * DFF2 + DFF + ff]; o[7] = cb[DFF + ff];
            }
            if (gtid < 2) {
                const int l = (int)gtid;
                float s1 = 0.f, s2 = 0.f;
                for (int i = 0; i < 32; ++i) { s1 += inptr(p, 11)[l * 32 + i] * inptr(p, 12)[l * 32 + i]; s2 += inptr(p, 13)[l * 32 + i] * inptr(p, 14)[l * 32 + i]; }
                const float lam_init = 0.8f - 0.6f * expf(-0.3f * (float)l);
                ((float*)ctl)[CW_LAM + l] = expf(s1) - expf(s2) + lam_init;
            }
        } else if (ph == NPHASES - 1 && (SUBMASK & 0x200)) {
            const float* gf = inptr(p, 23);
            f32x4 gv[4];
#pragma unroll
            for (int j = 0; j < 4; ++j) gv[j] = *(const f32x4*)(gf + 256 * j + 4 * lane);
            for (int row0 = gw; row0 < MTOK; row0 += 4 * ngw) {
                f32x4 v[4][4];
#pragma unroll
                for (int q = 0; q < 4; ++q) {
                    const int row = row0 + q * ngw;
                    if (row < MTOK) {
#pragma unroll
                        for (int j = 0; j < 4; ++j) v[q][j] = *(const GAS f32x4*)(gptr(pout) + (long)row * DMODEL + 256 * j + 4 * lane);
                    }
                }
#pragma unroll
                for (int q = 0; q < 4; ++q) {
                    const int row = row0 + q * ngw;
                    if (row < MTOK) {
                        float ss = 0.f;
#pragma unroll
                        for (int j = 0; j < 4; ++j) ss += (v[q][j][0] * v[q][j][0] + v[q][j][1] * v[q][j][1]) + (v[q][j][2] * v[q][j][2] + v[q][j][3] * v[q][j][3]);
#pragma unroll
                        for (int o = 1; o < 64; o <<= 1) ss += __shfl_xor(ss, o);
                        const float rs = rsqrtf(ss * (1.f / 1024.f) + EPS);
#pragma unroll
                        for (int j = 0; j < 4; ++j) *(GAS f32x4*)(gptr(pout) + (long)row * DMODEL + 256 * j + 4 * lane) = v[q][j] * rs * gv[j];
                    }
                }
            }
        } else {
            const int l = (ph - 1) / 7, sub = (ph - 1) % 7;
            unsigned char* wl = ws + WS_W + l * WL_STRIDE;
            const float* rs_attn = stat + (l == 0 ? ST_ATTN0 : ST_ATTN1) * MTOK;
            float* rs_ffn = stat + (l == 0 ? ST_FFN0 : ST_FFN1) * MTOK;
            float* sqq = stat + ST_SQQ * MTOK; float* sqkv = stat + ST_SQKV * MTOK;
            PG8_LAS unsigned char* lds3 = (PG8_LAS unsigned char*)smem;
            if (sub == 0 && (SUBMASK & 1)) {
                SchedInproj S; S.o.init(192, 9); S.XB = (const char*)XB; S.W = (const char*)(wl + WL_IN);
                EpiInproj E{EpiScaleStore<0>{H, HW, rs_attn, 1.f / 1024.f, HW, sqq, sqkv}, EpiScaleStore<1>{VT, MTOK, rs_attn, 1.f / 1024.f, MTOK, nullptr, nullptr}};
                pg8::gemm_phase<false>(lds3, wid, DMODEL, DMODEL, DMODEL, S, E); if (PROBE_GEMM > 1) pg8::gemm_phase<false>(lds3, wid, DMODEL, DMODEL, DMODEL, S, E);
            } else if (sub == 2 && (SUBMASK & 4)) {
                const float* gq = inptr(p, 9) + l * 64; const float* gk = inptr(p, 10) + l * 64;
                int col = -1, kind = 0;
                if (lane < 32) { col = 1024 + 8 * lane; kind = 1; } else if (lane < 48) { col = 384 + 8 * (lane - 32); kind = 2; } else if (lane < 52) { col = 896 + 8 * (lane - 48); kind = 3; }
                auto proc = [&](const int row, const u32x4 raw, const u32x4 r2) __attribute__((always_inline)) {
                    bf16_t* hr = H + (long)row * HW;
                    const int pos = tok_pos(row);
                    float y[8];
                    y[0] = bflo(raw.x); y[1] = bfhi(raw.x); y[2] = bflo(raw.y); y[3] = bfhi(raw.y); y[4] = bflo(raw.z); y[5] = bfhi(raw.z); y[6] = bflo(raw.w); y[7] = bfhi(raw.w);
                    float ss = 0.f;
#pragma unroll
                    for (int e = 0; e < 8; ++e) ss += y[e] * y[e];
                    ss += __shfl_xor(ss, 1); ss += __shfl_xor(ss, 2); ss += __shfl_xor(ss, 4);
                    const int j = lane & 7;
                    if (kind == 1 || kind == 2) {
                        const float rs = rsqrtf(ss * (1.f / 64.f) + EPS) * (kind == 1 ? 0.125f * LOG2E : 1.f);
                        const float* gg = (kind == 1 ? gq : gk) + 8 * j;
#pragma unroll
                        for (int e = 0; e < 8; ++e) y[e] = y[e] * rs * gg[e];
                    }
                    const int rp = (kind == 3) ? pos : ((j < 4) ? (pos >> 6) : (pos & 63));
                    const bool isx2 = (j & 2) != 0;
                    const float* tb = rope + ((long)rp * 16 + 8 * (j & 1)) * 2;
#pragma unroll
                    for (int e = 0; e < 8; ++e) {
                        const float pvv = __shfl_xor(y[e], 2);
                        const float c = tb[2 * e], s = tb[2 * e + 1];
                        y[e] = isx2 ? (y[e] * c + pvv * s) : (y[e] * c - pvv * s);
                    }
                    if (kind) { u32x4 o; o.x = pk2(y[0], y[1]); o.y = pk2(y[2], y[3]); o.z = pk2(y[4], y[5]); o.w = pk2(y[6], y[7]); *(u32x4*)(hr + col) = o; }
                };
                const u32x4 zero4 = (u32x4){0u, 0u, 0u, 0u};
                for (int row0 = gw; row0 < MTOK; row0 += 4 * ngw) {
                    u32x4 raw[4], r2[4];
#pragma unroll
                    for (int q = 0; q < 4; ++q) {
                        const int row = row0 + q * ngw; raw[q] = zero4; r2[q] = zero4;
                        if (row < MTOK) {
                            const GAS bf16_t* hr = gptr(H) + (long)row * HW;
                            if (kind) raw[q] = *(const GAS u32x4*)(hr + col);
                        }
                    }
#pragma unroll
                    for (int q = 0; q < 4; ++q) { const int row = row0 + q * ngw; if (row < MTOK) proc(row, raw[q], r2[q]); }
                }
                {
                    SchedStd S; S.o.init(192, 2); S.A = (const char*)(H + 512); S.B = (const char*)(wl + WL_QUP); S.astride = 256L * HW * 2; S.bstride = 256L * 256 * 2;
                    EpiQup E{QB, sqq, rope};
                    pg8::gemm_phase<false>(lds3, wid, 256, HW, 256, S, E);
                }
                {
                    SchedStd S; S.o.init(192, 1); S.A = (const char*)(H + 768); S.B = (const char*)(wl + WL_KUP); S.astride = 256L * HW * 2; S.bstride = 0;
                    EpiScaleStore<0> E{KBN, 256, sqkv, 1.f / 128.f, 256, nullptr, nullptr};
                    pg8::gemm_phase<false>(lds3, wid, 128, HW, 128, S, E);
                }
                {
                    SchedStd S; S.o.init(1, 192); S.A = (const char*)(wl + WL_VUP); S.B = (const char*)(H + 768); S.astride = 0; S.bstride = 256L * HW * 2;
                    EpiScaleStore<1> E{VT + 512L * MTOK, MTOK, sqkv, 1.f / 128.f, MTOK, nullptr, nullptr};
                    pg8::gemm_phase<false>(lds3, wid, 128, 128, HW, S, E);
                }
            } else if (sub == 3 && (SUBMASK & 8)) {
                if (l == 0) { for (long i = gtid; i < 2L * MTOK; i += gthreads) stat[(long)ST_SQQ * MTOK + i] = 0.f; }
                int* sh_u = (int*)(smem + LDS_MISC);
                const float lam = ((const float*)ctl)[CW_LAM + l];
                const float lam_init = 0.8f - 0.6f * expf(-0.3f * (float)l);
#define ATTN_QUEUE(QI, NUNITS, NP, BODY) \
                for (;;) { \
                      \
                    if (wid == 0) { \
                        const int ln_ = lane_id(); \
                        unsigned* cb_ = ctl + CW_ATTN_CTR + 1024 * rep + 64 * (4 * l + QI); \
                        const unsigned c_ = (ln_ < 8) ? __hip_atomic_load(cb_ + ((myx + ln_) & 7), __ATOMIC_RELAXED, __HIP_MEMORY_SCOPE_AGENT) : (unsigned)(NUNITS); \
                        const unsigned long long m_ = __ballot(c_ < (unsigned)(NUNITS)); \
                        int res_ = -1; \
                        if (m_) { const int x_ = (myx + (__ffsll((long long)m_) - 1)) & 7; \
                            unsigned u_ = 0u; if (ln_ == 0) u_ = atomicAdd(cb_ + x_, 1u); u_ = (unsigned)__shfl((int)u_, 0); \
                            res_ = (u_ < (unsigned)(NUNITS)) ? ((x_ << 8) | (int)u_) : -2; } \
                        if (ln_ == 0) *sh_u = res_; \
                    } \
                    __syncthreads(); \
                    const int r_ = *sh_u; \
                    __syncthreads(); \
                    if (r_ == -1) break; \
                    if (r_ == -2) continue; \
                    const int xcd = r_ >> 8, u = r_ & 255; \
                    int h, qb, S; long row0; \
                      \
                    if (u < (NP)) { const int ix = (u >> 4) * 8 + xcd; h = ((NUNITS) == 96) ? (ix & 3) : 2 * (ix & 1); qb = u & 15; row0 = (long)(((NUNITS) == 96) ? (ix >> 2) : (ix >> 1)) * SEQP; S = SEQP; } \
                    else { const int v = u - (NP); const int ix = (v >> 3) * 8 + xcd; h = ((NUNITS) == 96) ? (ix & 3) : 2 * (ix & 1); qb = v & 7; row0 = MPROMPT + (long)(((NUNITS) == 96) ? (ix >> 2) : (ix >> 1)) * SEQS; S = SEQS; } \
                    AttnArgs a; \
                    a.row0 = row0; a.S = S; a.q0 = qb * 256; a.K2 = H; a.ldk2 = 0; a.sink2 = 0.f; a.lam = 0.f; a.post = 0.f; a.subn = inptr(p, 15); a.slope2 = 0.f; \
                    BODY \
                }
                const int myx = (int)(xb_xcc_id() & 7u);
                for (int rep = 0; rep < PROBE_ATTN; ++rep) {
                if ((ATMODE & 8) && (rep == 0 || (PROBE_WHICH & 8))) ATTN_QUEUE(0, 96, 64, {
                    a.Q = H + 1280 + h * 64; a.ldq = HW; a.K = H + 1536 + h * 64; a.ldk = HW; a.VT = VT + (long)(256 + h * 64) * MTOK; a.O = ATT + 768 + h * 64;
                    a.slope2 = exp2f(-(float)(h + 5)) * LOG2E; a.lam = lam; a.post = 1.f - lam_init; a.subn = inptr(p, 15) + l * 64;
                    attn_unit<3>(a, smem, wid * 64 + lane_id()); })
                if ((ATMODE & 2) && (rep == 0 || (PROBE_WHICH & 2))) ATTN_QUEUE(1, 96, 64, {
                    a.Q = QB + h * 96; a.ldq = 384; a.K = KBN + h * 64; a.ldk = 256; a.K2 = H + 896; a.ldk2 = HW; a.VT = VT + (long)(512 + h * 64) * MTOK; a.O = ATT + 256 + h * 64;
                    attn_unit<1>(a, smem, wid * 64 + lane_id()); })
                if ((ATMODE & 4) && (rep == 0 || (PROBE_WHICH & 4))) ATTN_QUEUE(2, 48, 32, {
                    a.Q = H + 1024 + h * 64; a.ldq = HW; a.K = H + 384 + (h >> 1) * 64; a.ldk = HW; a.VT = VT + (long)(128 + (h >> 1) * 64) * MTOK; a.O = ATT + 512 + h * 64;
                    attn_unit_pairC(a, smem, wid * 64 + lane_id()); })
                if ((ATMODE & 1) && (rep == 0 || (PROBE_WHICH & 1))) ATTN_QUEUE(3, 96, 64, {
                    a.Q = H + h * 64; a.ldq = HW; a.K = H + 256 + (h >> 1) * 64; a.ldk = HW; a.VT = VT + (long)((h >> 1) * 64) * MTOK; a.O = ATT + h * 64;
                    a.slope2 = exp2f(-(float)(h + 1)) * LOG2E; a.sink2 = inptr(p, 4)[l * 4 + h] * LOG2E;
                    attn_unit<0>(a, smem, wid * 64 + lane_id()); })
                }
#undef ATTN_QUEUE
            } else if (sub == 4 && (SUBMASK & 16)) {
                EpiResid E{l == 0 ? inptr(p, 0) : pout, l == 0 ? inptr(p, 1) : pout + (long)MPROMPT * DMODEL, pout, XB, rs_ffn};
                SchedStd S; S.o.init(192, 4); S.A = (const char*)ATT; S.B = (const char*)(wl + WL_OUT); S.astride = 256L * DMODEL * 2; S.bstride = 256L * DMODEL * 2;
                pg8::gemm_phase<false>(lds3, wid, DMODEL, DMODEL, DMODEL, S, E);
            } else if (sub == 5 && (SUBMASK & 32)) {
                EpiConvGate E{Gb, rs_ffn, inptr(p, 19) + (long)l * DFF2, (const float*)(ws + WS_CP) + (long)l * DFF * 8, (float*)(smem + LDS_XCH)};
                SchedStd S; S.o.init(194, 22); S.A = (const char*)(XB - DMODEL); S.B = (const char*)(wl + WL_UP); S.astride = 254L * DMODEL * 2; S.bstride = 256L * DMODEL * 2;
                pg8::gemm_phase<true>(lds3, wid, DMODEL, DMODEL, DMODEL, S, E); if (PROBE_GEMM > 1) pg8::gemm_phase<true>(lds3, wid, DMODEL, DMODEL, DMODEL, S, E);
            } else if (sub == 6 && (SUBMASK & 64)) {
                EpiResid E{pout, pout + (long)MPROMPT * DMODEL, pout, XB, l == 0 ? stat + ST_ATTN1 * MTOK : nullptr};
                SchedStd S; S.o.init(192, 4, 1); S.A = (const char*)Gb; S.B = (const char*)(wl + WL_DOWN); S.astride = 256L * DFF * 2; S.bstride = 256L * DFF * 2;
                pg8::gemm_phase<false>(lds3, wid, DFF, DFF, DFF, S, E);
            }
        }
}

__global__ void __launch_bounds__(NTHREADS) fwd_kernel(Params p) {
    extern __shared__ __attribute__((aligned(16))) unsigned char smem[];
    const int wid = __builtin_amdgcn_readfirstlane((int)(threadIdx.x >> 6));
    const int lo = p.ph_lo, hi = p.ph_hi;
    if (lo < -5) cg::this_grid().sync();
    { volatile LAS unsigned* st0 = (volatile LAS unsigned*)((LAS unsigned char*)smem + LDS_MISC + 16); if (wid == 0 && lane_id() < 4) st0[lane_id()] = 0u; }
    __syncthreads();
    const XcdBarrier xbar = xcd_barrier_post((unsigned*)(p.ws + WS_CTL) + CW_XBAR, (volatile LAS unsigned*)((LAS unsigned char*)smem + LDS_MISC + 16), wid);
#define RUN(k) if (lo <= (k) && (k) < hi && (k) != 2 && (k) != 9) { run_phase<k>(p, wid, smem); if ((k) == 0 && PROBE_P0 > 1) run_phase<k>(p, wid, smem); if ((k) + 1 < hi) { for (int r_ = 0; r_ < PROBE_BAR; ++r_) xcd_barrier(xbar, wid); } }
    RUN(0) RUN(1) RUN(2) RUN(3) RUN(4) RUN(5) RUN(6) RUN(7) RUN(8) RUN(9) RUN(10) RUN(11) RUN(12) RUN(13) RUN(14) RUN(15)
#undef RUN
}

extern "C" void kernel_launch(void* const* d_in, const int* in_sizes, int n_in, void* d_out, int out_size, void* d_ws, size_t ws_size, hipStream_t stream) {
    static int grid = 0;
    if (grid == 0) {
        if (n_in != 24 || out_size != MTOK * DMODEL || ws_size < WS_END) { fprintf(stderr, "kernel_launch: unexpected shapes (n_in %d out %d ws %zu)\n", n_in, out_size, ws_size); grid = -1; return; }
        int dev = 0, cus = 0, per_cu = 0;
        hipGetDevice(&dev);
        hipDeviceGetAttribute(&cus, hipDeviceAttributeMultiprocessorCount, dev);
        if (hipFuncSetAttribute((const void*)fwd_kernel, hipFuncAttributeMaxDynamicSharedMemorySize, LDS_BYTES) != hipSuccess) { fprintf(stderr, "hipFuncSetAttribute failed\n"); grid = -1; return; }
        hipOccupancyMaxActiveBlocksPerMultiprocessor(&per_cu, (const void*)fwd_kernel, NTHREADS, LDS_BYTES);
        if (per_cu < 1) per_cu = 1;
        if (per_cu > 1) per_cu = 1;
        grid = cus * per_cu;
    }
    if (grid < 0) return;
    hipMemsetAsync((char*)d_ws + WS_CTL, 0, 32768, stream);
    Params p{};
    for (int i = 0; i < 24; ++i) p.in[i] = (const float*)d_in[i];
    p.out = (float*)d_out; p.ws = (unsigned char*)d_ws;
#if ONE_LAUNCH
    p.ph_lo = 0; p.ph_hi = NPHASES;
    void* args[] = {&p};
    hipError_t e = hipLaunchCooperativeKernel((const void*)fwd_kernel, dim3(grid), dim3(NTHREADS), args, LDS_BYTES, stream);
    if (e != hipSuccess) fprintf(stderr, "cooperative launch failed: %s (grid %d)\n", hipGetErrorString(e), grid);
#else
    for (int ph = 0; ph < NPHASES; ++ph) {
        p.ph_lo = ph; p.ph_hi = ph + 1;
        hipLaunchKernelGGL(fwd_kernel, dim3(grid), dim3(NTHREADS), LDS_BYTES, stream, p);
    }
#endif
}
```

```cpp
#include <hip/hip_runtime.h>
#include <hip/hip_cooperative_groups.h>
#include <cstdio>
#include <cstdint>
namespace cg = cooperative_groups;

#ifndef SUBMASK
#define SUBMASK 0xffff
#endif
#ifndef SUB2B
#define SUB2B 7
#endif
#ifndef ATMODE
#define ATMODE 15
#endif
#ifndef PROBE_ATTN
#define PROBE_ATTN 1
#endif
#ifndef PROBE_GEMM
#define PROBE_GEMM 1
#endif
#ifndef PROBE_P0
#define PROBE_P0 1
#endif
#ifndef PROBE_BAR
#define PROBE_BAR 1
#endif
#ifndef PROBE_WHICH
#define PROBE_WHICH 15
#endif
#ifndef ONE_LAUNCH
#define ONE_LAUNCH 1
#endif

#define DI __device__ __forceinline__
typedef unsigned short bf16_t;
typedef short bf16x8 __attribute__((ext_vector_type(8)));
typedef short s16x4 __attribute__((ext_vector_type(4)));
typedef float f32x4 __attribute__((ext_vector_type(4)));
typedef float f32x16 __attribute__((ext_vector_type(16)));
typedef unsigned u32x4 __attribute__((ext_vector_type(4)));
typedef unsigned u32x2 __attribute__((ext_vector_type(2)));
typedef float f32x2_t __attribute__((ext_vector_type(2)));
typedef __bf16 bf16x2_t __attribute__((ext_vector_type(2)));

DI unsigned pk2(float lo, float hi) { f32x2_t v = {lo, hi}; bf16x2_t b = __builtin_convertvector(v, bf16x2_t); return __builtin_bit_cast(unsigned, b); }
#define GAS __attribute__((address_space(1)))
#define LAS __attribute__((address_space(3)))
template <class T> DI GAS T* gptr(T* p) { return (GAS T*)p; }
template <class T> DI const GAS T* gptr(const T* p) { return (const GAS T*)p; }
DI int lane_id() { int l = (int)__builtin_amdgcn_mbcnt_hi(~0u, __builtin_amdgcn_mbcnt_lo(~0u, 0u)); asm volatile("" : "+v"(l)); return l; }
DI float bflo(unsigned u) { return __uint_as_float(u << 16); }
DI float bfhi(unsigned u) { return __uint_as_float(u & 0xffff0000u); }

constexpr int DMODEL = 1024, MTOK = 49152, MPROMPT = 32768, SEQP = 4096, SEQS = 2048;
constexpr int INW = 2208, HW = 1792, DFF = 2816, DFF2 = 5632;
constexpr float EPS = 1e-6f;
constexpr float LOG2E = 1.4426950408889634f;
constexpr int NTHREADS = 512;
constexpr int NPHASES = 16;

constexpr size_t MiB = 1u << 20;
constexpr size_t WS_CTL = 0;
constexpr size_t WS_STAT = 1 * MiB;
constexpr size_t WS_CP = 1 * MiB + 1536 * 1024;
constexpr size_t WS_ROPE = 3 * MiB;
constexpr size_t WS_W = 4 * MiB;
constexpr size_t WL_IN = 0, WL_QUP = 4718592, WL_KUP = WL_QUP + 262144, WL_VUP = WL_KUP + 65536, WL_OUT = WL_VUP + 65536,
                 WL_UP = WL_OUT + 2097152, WL_DOWN = WL_UP + 11534336, WL_STRIDE = 24 * MiB;
static_assert(WL_DOWN + 5767168 <= WL_STRIDE, "weights per layer");
constexpr size_t WS_H = 52 * MiB;
constexpr size_t WS_VT = 220 * MiB;
constexpr size_t WS_G = 52 * MiB;
constexpr size_t WS_XB = 317 * MiB;
constexpr size_t WS_QB = WS_XB;
constexpr size_t WS_KBN = WS_XB + 36 * MiB;
constexpr size_t WS_ATT = 414 * MiB;
constexpr size_t WS_END = 510 * MiB;
constexpr int ST_ATTN0 = 0, ST_FFN0 = 1, ST_ATTN1 = 2, ST_FFN1 = 3, ST_SQQ = 4, ST_SQKV = 5;
constexpr int CW_ATTN_CTR = 0;
constexpr int CW_LAM = 600;
constexpr int CW_GBAR = 704;
constexpr int CW_XBAR = 4096;

constexpr int LDS_XCH = 131072, LDS_MISC = LDS_XCH + 4096, LDS_BYTES = LDS_MISC + 64;
struct Params {
    const float* in[24];
    float* out;
    unsigned char* ws;
    int ph_lo, ph_hi;
};

namespace pg8 {
#define PG8_LAS __attribute__((address_space(3)))
constexpr int BM = 256, BK = 64, HALF = 128, HTB = HALF * BK * 2  , STAGE_BYTES = 8 * HTB, NXCD = 8, WGM = 8;

__host__ __device__ __forceinline__ int lds_byte(int r, int c) { const int st = (r >> 4) * 2 + (c >> 5), rr = r & 15, cc = c & 31, ob = rr * 64 + cc * 2; return st * 1024 + (ob ^ (((ob >> 9) & 1) << 5)); }
__host__ __device__ __forceinline__ void stage_rc(int b, int& R, int& C) { const int st = b / 1024, sb = b % 1024, swz = sb ^ (((sb >> 9) & 1) << 5); R = (st >> 1) * 16 + swz / 64; C = (st & 1) * 32 + (swz % 64) / 2; }
__host__ __device__ __forceinline__ int perm32(int rho) { const int n = rho >> 4, i = rho & 15; return 8 * (i >> 2) + 4 * n + (i & 3); }
struct Unit { const char* A; const char* B; int pm, pn; };
template <bool PERMROWS, class Epi, class Sched>
__device__ __forceinline__ void gemm_phase(PG8_LAS unsigned char* lds, const int wid, const int K, const int lda, const int ldb, const Sched& S, const Epi& E) {
    constexpr bool ALIGN_EPI = true, SP2 = true;
    const int lane = lane_id(), tid = wid * 64 + lane, wr = wid >> 2, wc = wid & 3, fr = lane & 15, fq = lane >> 4;
    const int nt = K / BK;
    unsigned voffA[2], voffB[2];
#pragma unroll
    for (int i = 0; i < 2; ++i) { int R, C; stage_rc(tid * 16 + i * 8192, R, C); const int Rb = (R & ~31) + perm32(R & 31);
        const int Ra = PERMROWS ? (8 * (16 * (R >> 6) + (R & 15)) + ((R >> 4) & 3)) : R;
        voffA[i] = (unsigned)(Ra * lda + C) * 2u; voffB[i] = (unsigned)(Rb * ldb + C) * 2u; }
    const size_t kstep = (size_t)(BK * 2);
    const size_t hstepA = (size_t)(PERMROWS ? 4 : HALF) * lda * 2, hstepB = (size_t)HALF * ldb * 2;
    const unsigned ldsw = (unsigned)wid * 1024u;
    const int aoff = lds_byte(wr * 64 + fr, fq * 8), boff = lds_byte(wc * 32 + fr, fq * 8);
#define PG8_SA(b, h) (((b) * 2 + (h)) * HTB)
#define PG8_SB(b, h) ((4 + (b) * 2 + (h)) * HTB)
#define PG8_STAGE(bufoff, gbase, voff) do { _Pragma("unroll") for (int _i = 0; _i < 2; ++_i) \
        __builtin_amdgcn_global_load_lds((const unsigned*)((const char*)(gbase) + (voff)[_i]), (PG8_LAS unsigned*)(lds + (bufoff) + ldsw + _i * 8192), 16, 0, 0); } while (0)
#define PG8_LDA(dst, b, h) do { _Pragma("unroll") for (int m = 0; m < 4; ++m) _Pragma("unroll") for (int k = 0; k < 2; ++k) dst[m][k] = *(const PG8_LAS bf16x8*)(lds + PG8_SA(b, h) + aoff + m * 2048 + k * 1024); } while (0)
#define PG8_LDB(dst, b, h) do { _Pragma("unroll") for (int n = 0; n < 2; ++n) _Pragma("unroll") for (int k = 0; k < 2; ++k) dst[n][k] = *(const PG8_LAS bf16x8*)(lds + PG8_SB(b, h) + boff + n * 2048 + k * 1024); } while (0)
#define PG8_MMA(ai, bj, At, Bt) do { __builtin_amdgcn_s_setprio(1); _Pragma("unroll") for (int m = 0; m < 4; ++m) _Pragma("unroll") for (int n = 0; n < 2; ++n) _Pragma("unroll") for (int k = 0; k < 2; ++k) \
        acc[ai][bj][m][n] = __builtin_amdgcn_mfma_f32_16x16x32_bf16(Bt[n][k], At[m][k], acc[ai][bj][m][n], 0, 0, 0); __builtin_amdgcn_s_setprio(0); } while (0)
#define PG8_WAIT_V(n) asm volatile("s_waitcnt vmcnt(" #n ")" ::: "memory")
#define PG8_WAIT_L(n) asm volatile("s_waitcnt lgkmcnt(" #n ")" ::: "memory")
#define PG8_BAR __builtin_amdgcn_s_barrier()
#define PG8_SCHED __builtin_amdgcn_sched_barrier(0)
    Unit cur, nxt; int ui = 0;
    if (!S.next(0, cur)) return;
    f32x4 acc[2][2][4][2];
#pragma unroll
    for (int a = 0; a < 2; ++a)
#pragma unroll
        for (int b = 0; b < 2; ++b)
#pragma unroll
            for (int m = 0; m < 4; ++m)
#pragma unroll
                for (int n = 0; n < 2; ++n) acc[a][b][m][n] = (f32x4){0.f, 0.f, 0.f, 0.f};
    bf16x8 At[4][2], B0[2][2], B1[2][2];
    const char* cA = cur.A; const char* cB = cur.B;
    if constexpr (SP2) {
        PG8_STAGE(PG8_SB(0, 0), cB, voffB); PG8_STAGE(PG8_SB(0, 1), cB + hstepB, voffB); PG8_STAGE(PG8_SA(0, 0), cA, voffA); PG8_STAGE(PG8_SA(0, 1), cA + hstepA, voffA);
        if (wr == 1) PG8_BAR;
        PG8_WAIT_V(2); PG8_BAR;
        PG8_STAGE(PG8_SB(1, 0), cB + kstep, voffB); PG8_STAGE(PG8_SA(1, 0), cA + kstep, voffA); PG8_STAGE(PG8_SB(1, 1), cB + hstepB + kstep, voffB);
        PG8_WAIT_V(6); PG8_BAR;
    } else {
        PG8_STAGE(PG8_SB(0, 0), cB, voffB); PG8_STAGE(PG8_SA(0, 0), cA, voffA); PG8_STAGE(PG8_SB(0, 1), cB + hstepB, voffB); PG8_STAGE(PG8_SA(0, 1), cA + hstepA, voffA);
        if (wr == 1) PG8_BAR;
        PG8_WAIT_V(4); PG8_BAR;
        PG8_STAGE(PG8_SB(1, 0), cB + kstep, voffB); PG8_STAGE(PG8_SA(1, 0), cA + kstep, voffA); PG8_STAGE(PG8_SB(1, 1), cB + hstepB + kstep, voffB);
        PG8_WAIT_V(6); PG8_BAR;
    }
    for (;;) {
        const bool has_next = S.next(ui + 1, nxt);
        const char* nA = has_next ? nxt.A : cA; const char* nB = has_next ? nxt.B : cB;
#pragma unroll 1
        for (int t = 0; t < nt; t += 2) {
            const bool last = (t == nt - 2);
            const char* a1 = cA + (size_t)(t + 1) * kstep;
            const char* a2 = last ? nA : cA + (size_t)(t + 2) * kstep; const char* b2 = last ? nB : cB + (size_t)(t + 2) * kstep;
            const char* a3 = a2 + kstep; const char* b3 = b2 + kstep;
            if constexpr (SP2) {
            PG8_LDB(B0, 0, 0); PG8_LDB(B1, 0, 1); PG8_SCHED; PG8_LDA(At, 0, 0); PG8_STAGE(PG8_SA(1, 1), a1 + hstepA, voffA);
            PG8_WAIT_V(8); PG8_WAIT_L(0); PG8_BAR; PG8_MMA(0, 0, At, B0); PG8_MMA(0, 1, At, B1); PG8_BAR; PG8_SCHED;
            PG8_LDA(At, 0, 1); PG8_STAGE(PG8_SB(0, 0), b2, voffB); PG8_STAGE(PG8_SB(0, 1), b2 + hstepB, voffB); PG8_STAGE(PG8_SA(0, 0), a2, voffA);
            PG8_WAIT_V(8); PG8_WAIT_L(0); PG8_BAR; PG8_MMA(1, 0, At, B0); PG8_MMA(1, 1, At, B1); PG8_BAR; PG8_SCHED;
            PG8_LDB(B0, 1, 0); PG8_LDB(B1, 1, 1); PG8_SCHED; PG8_LDA(At, 1, 0); PG8_STAGE(PG8_SA(0, 1), a2 + hstepA, voffA);
            PG8_WAIT_V(8); PG8_WAIT_L(0); PG8_BAR; PG8_MMA(0, 0, At, B0); PG8_MMA(0, 1, At, B1); PG8_BAR; PG8_SCHED;
            PG8_LDA(At, 1, 1); PG8_STAGE(PG8_SB(1, 0), b3, voffB); PG8_STAGE(PG8_SB(1, 1), b3 + hstepB, voffB); PG8_STAGE(PG8_SA(1, 0), a3, voffA);
            PG8_WAIT_V(8); PG8_WAIT_L(0); PG8_BAR; PG8_MMA(1, 0, At, B0); PG8_MMA(1, 1, At, B1); PG8_BAR; PG8_SCHED;
            } else {
            PG8_LDB(B0, 0, 0); PG8_SCHED; PG8_LDA(At, 0, 0); PG8_STAGE(PG8_SA(1, 1), a1 + hstepA, voffA);
            PG8_WAIT_L(8); PG8_BAR; PG8_WAIT_L(0); PG8_MMA(0, 0, At, B0); PG8_BAR; PG8_SCHED;
            PG8_LDB(B1, 0, 1); PG8_STAGE(PG8_SB(0, 0), b2, voffB);
            PG8_BAR; PG8_WAIT_L(0); PG8_MMA(0, 1, At, B1); PG8_BAR;
            PG8_LDA(At, 0, 1); PG8_STAGE(PG8_SA(0, 0), a2, voffA);
            PG8_BAR; PG8_WAIT_L(0); PG8_MMA(1, 0, At, B0); PG8_BAR; PG8_SCHED;
            PG8_STAGE(PG8_SB(0, 1), b2 + hstepB, voffB);
            PG8_WAIT_V(6); PG8_BAR; PG8_MMA(1, 1, At, B1); PG8_BAR;
            PG8_LDB(B0, 1, 0); PG8_SCHED; PG8_LDA(At, 1, 0); PG8_STAGE(PG8_SA(0, 1), a2 + hstepA, voffA);
            PG8_WAIT_L(8); PG8_BAR; PG8_WAIT_L(0); PG8_MMA(0, 0, At, B0); PG8_BAR; PG8_SCHED;
            PG8_LDB(B1, 1, 1); PG8_STAGE(PG8_SB(1, 0), b3, voffB);
            PG8_BAR; PG8_WAIT_L(0); PG8_MMA(0, 1, At, B1); PG8_BAR;
            PG8_LDA(At, 1, 1); PG8_STAGE(PG8_SA(1, 0), a3, voffA);
            PG8_BAR; PG8_WAIT_L(0); PG8_MMA(1, 0, At, B0); PG8_BAR; PG8_SCHED;
            PG8_STAGE(PG8_SB(1, 1), b3 + hstepB, voffB);
            PG8_WAIT_V(6); PG8_BAR; PG8_MMA(1, 1, At, B1); PG8_BAR;
            }
        }
        if constexpr (ALIGN_EPI) { if (wr == 0) PG8_BAR; }
        E(acc, cur, wr, wc);
        if (!has_next) break;
#pragma unroll
        for (int a = 0; a < 2; ++a)
#pragma unroll
            for (int b = 0; b < 2; ++b)
#pragma unroll
                for (int m = 0; m < 4; ++m)
#pragma unroll
                    for (int n = 0; n < 2; ++n) acc[a][b][m][n] = (f32x4){0.f, 0.f, 0.f, 0.f};
        cur = nxt; cA = nA; cB = nB; ++ui;
        if constexpr (ALIGN_EPI) { if (wr == 1) PG8_BAR; }
    }
    PG8_WAIT_V(0);
    if constexpr (!ALIGN_EPI) { if (wr == 0) PG8_BAR; }
    PG8_BAR;
#undef PG8_SA
#undef PG8_SB
#undef PG8_STAGE
#undef PG8_LDA
#undef PG8_LDB
#undef PG8_MMA
#undef PG8_WAIT_V
#undef PG8_WAIT_L
#undef PG8_BAR
#undef PG8_SCHED
}
}

struct Order {
    int nM, nN, nwg, G, c;
    DI void init(int nM_, int nN_) { nM = nM_; nN = nN_; nwg = nM * nN; G = gridDim.x; c = blockIdx.x; }
    DI bool next(int i, int& pm, int& pn) const {
        const long L = (long)i * G + c; if (L >= nwg) return false;
        int wgid = (int)L; { const int q = nwg / 8, r = nwg % 8, xcd = wgid % 8, off = wgid / 8; wgid = (xcd < r ? xcd * (q + 1) : r * (q + 1) + (xcd - r) * q) + off; }
        const int nig = 8 * nN, gid = wgid / nig, fm = gid * 8, gsz = (nM - fm) < 8 ? (nM - fm) : 8;
        pm = fm + ((wgid % nig) % gsz); pn = (wgid % nig) / gsz; return true;
    }
};
struct SchedStd {
    Order o; const char* A; const char* B; long astride, bstride;
    DI bool next(int i, pg8::Unit& u) const { int pm, pn; if (!o.next(i, pm, pn)) return false; u.pm = pm; u.pn = pn; u.A = A + pm * astride; u.B = B + pn * bstride; return true; }
};
struct SchedInproj {
    Order o; const char* XB; const char* W;
    DI bool next(int i, pg8::Unit& u) const { int pm, pn; if (!o.next(i, pm, pn)) return false; u.pm = pm; u.pn = pn;
        const char* xt = XB + (long)pm * 256 * DMODEL * 2;
        if (pn < 7) { u.A = xt; u.B = W + (long)pn * 256 * DMODEL * 2; } else { u.A = W + (long)(1792 + 256 * (pn - 7)) * DMODEL * 2; u.B = xt; }
        return true; }
};
template <int MODE>
struct EpiScaleStore {
    bf16_t* O; int ldo; const float* rsum; float invn; int ncols; float* sq0; float* sq1;
    DI void operator()(f32x4 (&acc)[2][2][4][2], const pg8::Unit& u, int wr, int wc) const { (*this)(acc, 256 * u.pm, 256 * u.pn, wr, wc); }
    DI void operator()(f32x4 (&acc)[2][2][4][2], int row0, int col0, int wr, int wc) const {
        const int lane_ = lane_id(), fr = lane_ & 15, fq = lane_ >> 4;
        float cs[2][8];
        if (MODE == 1) {
#pragma unroll
            for (int bj = 0; bj < 2; ++bj)
#pragma unroll
                for (int j = 0; j < 8; ++j) cs[bj][j] = rsqrtf(gptr(rsum)[(unsigned)(col0 + 128 * bj + 32 * wc + 8 * fq + j)] * invn + EPS);
        }
#pragma unroll
        for (int ai = 0; ai < 2; ++ai)
#pragma unroll
            for (int m = 0; m < 4; ++m) {
                const int row = row0 + 128 * ai + 64 * wr + 16 * m + fr;
                float rs = 1.f, ssq = 0.f;
                if (MODE == 0) rs = rsqrtf(gptr(rsum)[(unsigned)row] * invn + EPS);
#pragma unroll
                for (int bj = 0; bj < 2; ++bj) {
                    const int col = col0 + 128 * bj + 32 * wc + 8 * fq;
                    if (col >= ncols) continue;
                    f32x4 v0 = acc[ai][bj][m][0], v1 = acc[ai][bj][m][1];
                    if (MODE == 0) { v0 = v0 * rs; v1 = v1 * rs; }
                    else { v0 = v0 * (f32x4){cs[bj][0], cs[bj][1], cs[bj][2], cs[bj][3]}; v1 = v1 * (f32x4){cs[bj][4], cs[bj][5], cs[bj][6], cs[bj][7]}; }
                    u32x4 w; w.x = pk2(v0[0], v0[1]); w.y = pk2(v0[2], v0[3]); w.z = pk2(v1[0], v1[1]); w.w = pk2(v1[2], v1[3]);
                    *(GAS u32x4*)(gptr(O) + (unsigned)(row * ldo + col)) = w;
                    if (MODE == 0 && sq0 && (col0 == 512 || (col0 == 768 && bj == 0)))
                        ssq += (v0[0] * v0[0] + v0[1] * v0[1]) + (v0[2] * v0[2] + v0[3] * v0[3]) + (v1[0] * v1[0] + v1[1] * v1[1]) + (v1[2] * v1[2] + v1[3] * v1[3]);
                }
                if (MODE == 0 && sq0 && (col0 == 512 || col0 == 768)) {
                    ssq += __shfl_xor(ssq, 16); ssq += __shfl_xor(ssq, 32);
                    if (fq == 0 && (col0 == 512 || wc < 4)) atomicAdd((col0 == 512 ? sq0 : sq1) + row, ssq);
                }
                asm volatile("" ::: "memory");
            }
    }
};

struct EpiInproj {
    EpiScaleStore<0> eh; EpiScaleStore<1> ev;
    DI void operator()(f32x4 (&acc)[2][2][4][2], const pg8::Unit& u, int wr, int wc) const {
        if (u.pn < 7) eh(acc, 256 * u.pm, 256 * u.pn, wr, wc); else ev(acc, 256 * (u.pn - 7), 256 * u.pm, wr, wc);
    }
};
DI int tok_pos(int row) { return row < MPROMPT ? (row & (SEQP - 1)) : (row & (SEQS - 1)); }

struct EpiQup {
    bf16_t* QB; const float* sq; const float* rope;
    DI void operator()(f32x4 (&acc)[2][2][4][2], const pg8::Unit& u, int wr, int wc) const { (*this)(acc, 256L * u.pm, 256L * u.pn, wr, wc); }
    DI void operator()(f32x4 (&acc)[2][2][4][2], long row0, long col0, int wr, int wc) const {
        const int lane_ = lane_id(), fr = lane_ & 15, fq = lane_ >> 4;
#pragma unroll
        for (int ai = 0; ai < 2; ++ai)
#pragma unroll
            for (int m = 0; m < 4; ++m) {
                const int row = (int)row0 + 128 * ai + 64 * wr + 16 * m + fr;
                const float rs = rsqrtf(gptr(sq)[(unsigned)row] * (1.f / 256.f) + EPS);
                const int pos = tok_pos(row);
#pragma unroll
                for (int bj = 0; bj < 2; ++bj) {
                    const int col = (int)col0 + 128 * bj + 32 * wc + 8 * fq;
                    if (col >= 384) continue;
                    const f32x4 v0 = acc[ai][bj][m][0] * rs, v1 = acc[ai][bj][m][1] * rs;
                    const int head = col / 96, w = col - head * 96;
                    if (w < 64) {
                        u32x4 o; o.x = pk2(v0[0], v0[1]); o.y = pk2(v0[2], v0[3]); o.z = pk2(v1[0], v1[1]); o.w = pk2(v1[2], v1[3]);
                        *(GAS u32x4*)(gptr(QB) + (unsigned)(row * 384 + col)) = o;
                    } else {
                        const int g = (w - 64) >> 3;
                        const GAS f32x4* t = (const GAS f32x4*)(gptr(rope) + (unsigned)((pos * 16 + 4 * g) * 2));
                        const f32x4 t0 = t[0], t1 = t[1];
                        const float c[4] = {t0[0], t0[2], t1[0], t1[2]}, s[4] = {t0[1], t0[3], t1[1], t1[3]};
                        float o1[4], o2[4];
#pragma unroll
                        for (int e = 0; e < 4; ++e) { o1[e] = v0[e] * c[e] - v1[e] * s[e]; o2[e] = v1[e] * c[e] + v0[e] * s[e]; }
                        u32x2 a, b; a.x = pk2(o1[0], o1[1]); a.y = pk2(o1[2], o1[3]); b.x = pk2(o2[0], o2[1]); b.y = pk2(o2[2], o2[3]);
                        GAS bf16_t* q = gptr(QB) + (unsigned)(row * 384 + head * 96 + 64 + 4 * g);
                        *(GAS u32x2*)q = a; *(GAS u32x2*)(q + 16) = b;
                    }
                }
                asm volatile("" ::: "memory");
            }
    }
};

struct EpiResid {
    const float* xo0; const float* xo1; float* out; bf16_t* XB; float* rsum;
    DI void operator()(f32x4 (&acc)[2][2][4][2], const pg8::Unit& u, int wr, int wc) const { (*this)(acc, 256L * u.pm, 256L * u.pn, wr, wc); }
    DI void operator()(f32x4 (&acc)[2][2][4][2], long row0, long col0, int wr, int wc) const {
        const int lane_ = lane_id(), fr = lane_ & 15, fq = lane_ >> 4;
#pragma unroll
        for (int ai = 0; ai < 2; ++ai)
#pragma unroll
            for (int m = 0; m < 4; ++m) {
                const int row = (int)row0 + 128 * ai + 64 * wr + 16 * m + fr;
                const GAS float* xo = row < MPROMPT ? gptr(xo0) + (unsigned)(row * DMODEL) : gptr(xo1) + (unsigned)((row - MPROMPT) * DMODEL);
                float ss = 0.f;
#pragma unroll
                for (int bj = 0; bj < 2; ++bj) {
                    const int col = (int)col0 + 128 * bj + 32 * wc + 8 * fq;
                    const f32x4 v0 = acc[ai][bj][m][0] + *(const GAS f32x4*)(xo + col), v1 = acc[ai][bj][m][1] + *(const GAS f32x4*)(xo + col + 4);
                    *(GAS f32x4*)(gptr(out) + (unsigned)(row * DMODEL + col)) = v0; *(GAS f32x4*)(gptr(out) + (unsigned)(row * DMODEL + col + 4)) = v1;
                    u32x4 w; w.x = pk2(v0[0], v0[1]); w.y = pk2(v0[2], v0[3]); w.z = pk2(v1[0], v1[1]); w.w = pk2(v1[2], v1[3]);
                    *(GAS u32x4*)(gptr(XB) + (unsigned)(row * DMODEL + col)) = w;
                    ss += (v0[0] * v0[0] + v0[1] * v0[1]) + (v0[2] * v0[2] + v0[3] * v0[3]) + (v1[0] * v1[0] + v1[1] * v1[1]) + (v1[2] * v1[2] + v1[3] * v1[3]);
                }
                if (rsum) {
                    ss += __shfl_xor(ss, 16); ss += __shfl_xor(ss, 32);
                    if (fq == 0) atomicAdd(rsum + row, ss);
                }
                asm volatile("" ::: "memory");
            }
    }
};

DI bool seq_start(int g) { return g < MPROMPT ? ((g & (SEQP - 1)) == 0) : ((g & (SEQS - 1)) == 0); }
DI bool seq_end(int g) { return g < MPROMPT ? ((g & (SEQP - 1)) == SEQP - 1) : ((g & (SEQS - 1)) == SEQS - 1); }

struct EpiConvGate {
    bf16_t* G; const float* rsum; const float* bup; const float* cp; float* xch;
    DI void operator()(f32x4 (&acc)[2][2][4][2], const pg8::Unit& u, int wr, int wc) const { (*this)(acc, u.pm, u.pn, wr, wc); }
    DI void operator()(f32x4 (&acc)[2][2][4][2], int pm, int pn, int wr, int wc) const {
        const int lane_ = lane_id(), fr = lane_ & 15, fq = lane_ >> 4;
        const int G16 = 16 * wr + fr;
        const int g0 = 254 * pm - 1 + 8 * G16;
        const int ffb = 128 * pn + 32 * wc + 8 * fq;
        unsigned stm = 0u, enm = 0u;
#pragma unroll
        for (int jj = 0; jj < 8; ++jj) {
            const int g = g0 + jj; const bool ok = (g >= 0 && g < MTOK);
            const float rs = ok ? rsqrtf(gptr(rsum)[(unsigned)(ok ? g : 0)] * (1.f / 1024.f) + EPS) : 0.f;
            stm |= (seq_start(g) ? 1u : 0u) << jj; enm |= (seq_end(g) ? 1u : 0u) << jj;
#pragma unroll
            for (int bj = 0; bj < 2; ++bj)
#pragma unroll
                for (int n = 0; n < 2; ++n) {
                    const f32x4 bias = *(const GAS f32x4*)(gptr(bup) + (unsigned)(bj * DFF + ffb + 4 * n));
                    f32x4 h = acc[jj >> 2][bj][jj & 3][n] * rs + bias;
                    if (!ok) h = (f32x4){0.f, 0.f, 0.f, 0.f};
                    acc[jj >> 2][bj][jj & 3][n] = h;
                }
        }
        LAS f32x4* x0 = (LAS f32x4*)xch;
        if (fr == 15) {
#pragma unroll
            for (int bj = 0; bj < 2; ++bj)
#pragma unroll
                for (int n = 0; n < 2; ++n) x0[(((0 * 2 + wr) * 4 + wc) * 4 + fq) * 4 + bj * 2 + n] = acc[1][bj][3][n];
        }
        if (fr == 0) {
#pragma unroll
            for (int bj = 0; bj < 2; ++bj)
#pragma unroll
                for (int n = 0; n < 2; ++n) x0[(((1 * 2 + wr) * 4 + wc) * 4 + fq) * 4 + bj * 2 + n] = acc[0][bj][0][n];
        }
        asm volatile("s_waitcnt lgkmcnt(0)" ::: "memory"); __builtin_amdgcn_s_barrier(); asm volatile("" ::: "memory");
#pragma unroll
        for (int n = 0; n < 2; ++n) {
            unsigned ci = (unsigned)((ffb + 4 * n) * 2); asm volatile("" : "+v"(ci));
            const GAS f32x4* cpp = (const GAS f32x4*)gptr(cp) + ci;
            f32x4 prm[4][2];
#pragma unroll
            for (int e = 0; e < 4; ++e) { prm[e][0] = cpp[2 * e]; prm[e][1] = cpp[2 * e + 1]; }
            f32x4 pv[2], nx[2];
#pragma unroll
            for (int bj = 0; bj < 2; ++bj) {
#pragma unroll
                for (int e = 0; e < 4; ++e) { pv[bj][e] = __shfl_up(acc[1][bj][3][n][e], 1, 16); nx[bj][e] = __shfl_down(acc[0][bj][0][n][e], 1, 16); }
                if (fr == 0 && wr == 1) pv[bj] = x0[(((0 * 2 + 0) * 4 + wc) * 4 + fq) * 4 + bj * 2 + n];
                if (fr == 15 && wr == 0) nx[bj] = x0[(((1 * 2 + 1) * 4 + wc) * 4 + fq) * 4 + bj * 2 + n];
            }
#pragma unroll
            for (int hf = 0; hf < 2; ++hf) {
                unsigned opk[4][2];
#pragma unroll
                for (int ep = 0; ep < 2; ++ep) {
                    float val[4][2];
#pragma unroll
                    for (int eh = 0; eh < 2; ++eh) {
                        const int e = 2 * ep + eh;
                        const f32x4 pa = prm[e][0], pb = prm[e][1];
                        const float w0a = pa[0], w1a = pa[1], w2a = pa[2], ca0 = pa[3];
                        const float w0b = pb[0], w1b = pb[1], w2b = pb[2], cb0 = pb[3];
#pragma unroll
                        for (int j4 = 0; j4 < 4; ++j4) {
                            const int jj = 4 * hf + j4;
                            float hpa = jj == 0 ? pv[0][e] : acc[(jj - 1) >> 2][0][(jj - 1) & 3][n][e];
                            float hpb = jj == 0 ? pv[1][e] : acc[(jj - 1) >> 2][1][(jj - 1) & 3][n][e];
                            float hna = jj == 7 ? nx[0][e] : acc[(jj + 1) >> 2][0][(jj + 1) & 3][n][e];
                            float hnb = jj == 7 ? nx[1][e] : acc[(jj + 1) >> 2][1][(jj + 1) & 3][n][e];
                            if ((stm >> jj) & 1u) { hpa = 0.f; hpb = 0.f; }
                            if ((enm >> jj) & 1u) { hna = 0.f; hnb = 0.f; }
                            const float ha = acc[jj >> 2][0][jj & 3][n][e], hb = acc[jj >> 2][1][jj & 3][n][e];
                            const float ca = w0a * hpa + w1a * ha + w2a * hna + ca0;
                            const float cbv = w0b * hpb + w1b * hb + w2b * hnb + cb0;
                            val[j4][eh] = ca * __builtin_amdgcn_rcpf(1.f + __expf(-ca)) * cbv;
                        }
                    }
#pragma unroll
                    for (int j4 = 0; j4 < 4; ++j4) opk[j4][ep] = pk2(val[j4][0], val[j4][1]);
                }
#pragma unroll
                for (int j4 = 0; j4 < 4; ++j4) {
                    const int jj = 4 * hf + j4;
                    const int T = 8 * G16 + jj; const int g = g0 + jj;
                    if (T >= 1 && T <= 254 && g < MTOK) { u32x2 w; w.x = opk[j4][0]; w.y = opk[j4][1]; *(GAS u32x2*)(gptr(G) + ((unsigned)g * (unsigned)DFF + (unsigned)(ffb + 4 * n))) = w; }
                }
                asm volatile("" ::: "memory");
            }
            asm volatile("" ::: "memory");
        }
        asm volatile("s_waitcnt lgkmcnt(0)" ::: "memory"); __builtin_amdgcn_s_barrier(); asm volatile("" ::: "memory");
    }
};

constexpr int AT_KLD = 104, AT_VLD = 72;
constexpr int AT_KBUF = 64 * AT_KLD * 2, AT_VBUF = 64 * AT_VLD * 2;
constexpr int AT_VOFF = 2 * AT_KBUF, AT_BYTES = AT_VOFF + 2 * AT_VBUF;
struct AttnArgs {
    const bf16_t* Q; int ldq; const bf16_t* K; int ldk; const bf16_t* K2; int ldk2; const bf16_t* VT; bf16_t* O;
    long row0; int S; int q0; float slope2; float sink2; float lam; float post; const float* subn;
};
DI int crow(int r, int hi) { return (r & 3) + 8 * (r >> 2) + 4 * hi; }
constexpr float NEG_BIG = -1e30f;

#define SB() do {} while (0)
template <int NQ, int D0, bool ALIBI, bool WINDOW>
DI void attn_tile(const bf16x8* qf, const LAS unsigned char* kb, const LAS unsigned char* vbuf, float& mhat, f32x16& negm, float& l, f32x16 (&o)[2], float dq, float slope2, int r32, int hi, const bool first) {
    bf16x8 kf[2][NQ];
#pragma unroll
    for (int d0 = 0; d0 < NQ; ++d0)
#pragma unroll
        for (int blk = 0; blk < 2; ++blk) kf[blk][d0] = *(const LAS bf16x8*)(kb + ((32 * blk + r32) * AT_KLD + 16 * (D0 + d0) + 8 * hi) * 2);
    SB();
    f32x16 s[2];
#pragma unroll
    for (int d0 = 0; d0 < NQ; ++d0)
#pragma unroll
        for (int blk = 0; blk < 2; ++blk) s[blk] = __builtin_amdgcn_mfma_f32_32x32x16_bf16(kf[blk][d0], qf[D0 + d0], d0 == 0 ? negm : s[blk], 0, 0, 0);
    SB();
    bf16x8 vA[2][2], vB[2][2];
#pragma unroll
    for (int kk = 0; kk < 2; ++kk)
#pragma unroll
        for (int d = 0; d < 2; ++d) {
            vA[d][kk] = *(const LAS bf16x8*)(vbuf + ((32 * d + r32) * AT_VLD + 16 * kk + 8 * hi) * 2);
        }
    if (ALIBI || WINDOW) {
#pragma unroll
        for (int blk = 0; blk < 2; ++blk)
#pragma unroll
            for (int r = 0; r < 16; ++r) {
                const float dist = fabsf(dq - (float)(32 * blk + (r & 3) + 8 * (r >> 2)));
                float v = s[blk][r];
                if (ALIBI) v = v - slope2 * dist;
                if (WINDOW) v = dist > 128.f ? NEG_BIG : v;
                s[blk][r] = v;
            }
    }
    float mx = s[0][0];
#pragma unroll
    for (int r = 1; r < 16; ++r) mx = fmaxf(mx, s[0][r]);
#pragma unroll
    for (int r = 0; r < 16; ++r) mx = fmaxf(mx, s[1][r]);
    mx = fmaxf(mx, __shfl_xor(mx, 32));
    if (first || __any(mx > 8.f)) {
        const float dl = first ? mx : fmaxf(mx, 0.f);
        mhat += dl;
#pragma unroll
        for (int blk = 0; blk < 2; ++blk)
#pragma unroll
            for (int r = 0; r < 16; ++r) s[blk][r] -= dl;
#pragma unroll
        for (int r = 0; r < 16; ++r) negm[r] = -mhat;
        const float f = first ? 1.f : __builtin_amdgcn_exp2f(-dl);
        l *= f;
#pragma unroll
        for (int d = 0; d < 2; ++d)
#pragma unroll
            for (int r = 0; r < 16; ++r) o[d][r] *= f;
    }
    float ps = 0.f;
#pragma unroll
    for (int blk = 0; blk < 2; ++blk)
#pragma unroll
        for (int r = 0; r < 16; ++r) { const float p = __builtin_amdgcn_exp2f(s[blk][r]); s[blk][r] = p; ps += p; }
    l += ps;
    bf16x8 pf[2][2];
#pragma unroll
    for (int blk = 0; blk < 2; ++blk)
#pragma unroll
        for (int kk = 0; kk < 2; ++kk) {
            u32x4 pw; pw.x = pk2(s[blk][8 * kk + 0], s[blk][8 * kk + 1]); pw.y = pk2(s[blk][8 * kk + 2], s[blk][8 * kk + 3]);
            pw.z = pk2(s[blk][8 * kk + 4], s[blk][8 * kk + 5]); pw.w = pk2(s[blk][8 * kk + 6], s[blk][8 * kk + 7]);
            pf[blk][kk] = __builtin_bit_cast(bf16x8, pw);
        }
    SB();
#pragma unroll
    for (int kk = 0; kk < 2; ++kk)
#pragma unroll
        for (int d = 0; d < 2; ++d) {
            vB[d][kk] = *(const LAS bf16x8*)(vbuf + ((32 * d + r32) * AT_VLD + 32 + 16 * kk + 8 * hi) * 2);
        }
#pragma unroll
    for (int kk = 0; kk < 2; ++kk)
#pragma unroll
        for (int d = 0; d < 2; ++d) o[d] = __builtin_amdgcn_mfma_f32_32x32x16_bf16(vA[d][kk], pf[0][kk], o[d], 0, 0, 0);
    SB();
#pragma unroll
    for (int kk = 0; kk < 2; ++kk)
#pragma unroll
        for (int d = 0; d < 2; ++d) o[d] = __builtin_amdgcn_mfma_f32_32x32x16_bf16(vB[d][kk], pf[1][kk], o[d], 0, 0, 0);
    SB();
}


template <int NQ, int D0, bool ALIBI, bool WINDOW>
DI void attn_tile_x(const bf16x8* qf, const LAS unsigned char* kb, f32x16 (&s)[2], float& mhat, f32x16& negm, float& l, f32x16 (&o)[2], float dq, float slope2, int r32, int hi, const bool first) {
    bf16x8 kf[2][NQ];
#pragma unroll
    for (int d0 = 0; d0 < NQ; ++d0)
#pragma unroll
        for (int blk = 0; blk < 2; ++blk) kf[blk][d0] = *(const LAS bf16x8*)(kb + ((32 * blk + r32) * AT_KLD + 16 * (D0 + d0) + 8 * hi) * 2);
    SB();
#pragma unroll
    for (int d0 = 0; d0 < NQ; ++d0)
#pragma unroll
        for (int blk = 0; blk < 2; ++blk) s[blk] = __builtin_amdgcn_mfma_f32_32x32x16_bf16(kf[blk][d0], qf[D0 + d0], d0 == 0 ? negm : s[blk], 0, 0, 0);
    SB();
    if (ALIBI || WINDOW) {
#pragma unroll
        for (int blk = 0; blk < 2; ++blk)
#pragma unroll
            for (int r = 0; r < 16; ++r) {
                const float dist = fabsf(dq - (float)(32 * blk + (r & 3) + 8 * (r >> 2)));
                float v = s[blk][r];
                if (ALIBI) v = v - slope2 * dist;
                if (WINDOW) v = dist > 128.f ? NEG_BIG : v;
                s[blk][r] = v;
            }
    }
    float mx = s[0][0];
#pragma unroll
    for (int r = 1; r < 16; ++r) mx = fmaxf(mx, s[0][r]);
#pragma unroll
    for (int r = 0; r < 16; ++r) mx = fmaxf(mx, s[1][r]);
    mx = fmaxf(mx, __shfl_xor(mx, 32));
    if (first || __any(mx > 8.f)) {
        const float dl = first ? mx : fmaxf(mx, 0.f);
        mhat += dl;
#pragma unroll
        for (int blk = 0; blk < 2; ++blk)
#pragma unroll
            for (int r = 0; r < 16; ++r) s[blk][r] -= dl;
#pragma unroll
        for (int r = 0; r < 16; ++r) negm[r] = -mhat;
        const float f = first ? 1.f : __builtin_amdgcn_exp2f(-dl);
        l *= f;
#pragma unroll
        for (int d = 0; d < 2; ++d)
#pragma unroll
            for (int r = 0; r < 16; ++r) o[d][r] *= f;
    }
#pragma unroll
    for (int blk = 0; blk < 2; ++blk)
#pragma unroll
        for (int r = 0; r < 16; ++r) s[blk][r] = __builtin_amdgcn_exp2f(s[blk][r]);
}
DI void attn_tile_y(const f32x16 (&s)[2], const LAS unsigned char* vbuf, float& l, f32x16 (&o)[2], int r32, int hi) {
    bf16x8 vA[2][2], vB[2][2];
#pragma unroll
    for (int kk = 0; kk < 2; ++kk)
#pragma unroll
        for (int d = 0; d < 2; ++d) vA[d][kk] = *(const LAS bf16x8*)(vbuf + ((32 * d + r32) * AT_VLD + 16 * kk + 8 * hi) * 2);
    float ps = 0.f;
#pragma unroll
    for (int blk = 0; blk < 2; ++blk)
#pragma unroll
        for (int r = 0; r < 16; ++r) ps += s[blk][r];
    l += ps;
    bf16x8 pf[2][2];
#pragma unroll
    for (int blk = 0; blk < 2; ++blk)
#pragma unroll
        for (int kk = 0; kk < 2; ++kk) {
            u32x4 pw; pw.x = pk2(s[blk][8 * kk + 0], s[blk][8 * kk + 1]); pw.y = pk2(s[blk][8 * kk + 2], s[blk][8 * kk + 3]);
            pw.z = pk2(s[blk][8 * kk + 4], s[blk][8 * kk + 5]); pw.w = pk2(s[blk][8 * kk + 6], s[blk][8 * kk + 7]);
            pf[blk][kk] = __builtin_bit_cast(bf16x8, pw);
        }
    SB();
#pragma unroll
    for (int kk = 0; kk < 2; ++kk)
#pragma unroll
        for (int d = 0; d < 2; ++d) vB[d][kk] = *(const LAS bf16x8*)(vbuf + ((32 * d + r32) * AT_VLD + 32 + 16 * kk + 8 * hi) * 2);
#pragma unroll
    for (int kk = 0; kk < 2; ++kk)
#pragma unroll
        for (int d = 0; d < 2; ++d) o[d] = __builtin_amdgcn_mfma_f32_32x32x16_bf16(vA[d][kk], pf[0][kk], o[d], 0, 0, 0);
    SB();
#pragma unroll
    for (int kk = 0; kk < 2; ++kk)
#pragma unroll
        for (int d = 0; d < 2; ++d) o[d] = __builtin_amdgcn_mfma_f32_32x32x16_bf16(vB[d][kk], pf[1][kk], o[d], 0, 0, 0);
    SB();
}

template <int D0>
DI void attn_tile_d(const bf16x8* qf, const LAS unsigned char* kb, const LAS unsigned char* vbuf, float& mhat, float& l, f32x16 (&o)[2], const f32x16& pat,
                    const bool diag, const float adj, const float adj32, float dq, float slope2, int r32, int hi, const bool first) {
    __builtin_amdgcn_sched_barrier(0);
    bf16x8 kf[2][2];
#pragma unroll
    for (int d0 = 0; d0 < 2; ++d0)
#pragma unroll
        for (int blk = 0; blk < 2; ++blk) kf[blk][d0] = *(const LAS bf16x8*)(kb + ((32 * blk + r32) * AT_KLD + 16 * (D0 + d0) + 8 * hi) * 2);
    f32x16 s[2];
    if (!diag) {
#pragma unroll
        for (int d0 = 0; d0 < 2; ++d0)
#pragma unroll
            for (int blk = 0; blk < 2; ++blk) s[blk] = __builtin_amdgcn_mfma_f32_32x32x16_bf16(kf[blk][d0], qf[D0 + d0], d0 == 0 ? pat : s[blk], 0, 0, 0);
        const float sref0 = mhat - adj, sref1 = sref0 - adj32;
#pragma unroll
        for (int r = 0; r < 16; ++r) { s[0][r] -= sref0; s[1][r] -= sref1; }
    } else {
        const f32x16 zero16 = {0.f, 0.f, 0.f, 0.f, 0.f, 0.f, 0.f, 0.f, 0.f, 0.f, 0.f, 0.f, 0.f, 0.f, 0.f, 0.f};
#pragma unroll
        for (int d0 = 0; d0 < 2; ++d0)
#pragma unroll
            for (int blk = 0; blk < 2; ++blk) s[blk] = __builtin_amdgcn_mfma_f32_32x32x16_bf16(kf[blk][d0], qf[D0 + d0], d0 == 0 ? zero16 : s[blk], 0, 0, 0);
#pragma unroll
        for (int blk = 0; blk < 2; ++blk)
#pragma unroll
            for (int r = 0; r < 16; ++r) s[blk][r] = s[blk][r] - slope2 * fabsf(dq - (float)(32 * blk + (r & 3) + 8 * (r >> 2))) - mhat;
    }
    float mx = s[0][0];
#pragma unroll
    for (int r = 1; r < 16; ++r) mx = fmaxf(mx, s[0][r]);
#pragma unroll
    for (int r = 0; r < 16; ++r) mx = fmaxf(mx, s[1][r]);
    mx = fmaxf(mx, __shfl_xor(mx, 32));
    if (first || __any(mx > 8.f)) {
        const float dl = first ? mx : fmaxf(mx, 0.f);
        mhat += dl;
#pragma unroll
        for (int blk = 0; blk < 2; ++blk)
#pragma unroll
            for (int r = 0; r < 16; ++r) s[blk][r] -= dl;
        const float f = first ? 1.f : __builtin_amdgcn_exp2f(-dl);
        l *= f;
#pragma unroll
        for (int d = 0; d < 2; ++d)
#pragma unroll
            for (int r = 0; r < 16; ++r) o[d][r] *= f;
    }
    float ps = 0.f;
#pragma unroll
    for (int blk = 0; blk < 2; ++blk)
#pragma unroll
        for (int r = 0; r < 16; ++r) { const float p = __builtin_amdgcn_exp2f(s[blk][r]); s[blk][r] = p; ps += p; }
    l += ps;
    bf16x8 pf[2][2];
#pragma unroll
    for (int blk = 0; blk < 2; ++blk)
#pragma unroll
        for (int kk = 0; kk < 2; ++kk) {
            u32x4 pw; pw.x = pk2(s[blk][8 * kk + 0], s[blk][8 * kk + 1]); pw.y = pk2(s[blk][8 * kk + 2], s[blk][8 * kk + 3]);
            pw.z = pk2(s[blk][8 * kk + 4], s[blk][8 * kk + 5]); pw.w = pk2(s[blk][8 * kk + 6], s[blk][8 * kk + 7]);
            pf[blk][kk] = __builtin_bit_cast(bf16x8, pw);
        }
    bf16x8 vA[2][2], vB[2][2];
#pragma unroll
    for (int kk = 0; kk < 2; ++kk)
#pragma unroll
        for (int d = 0; d < 2; ++d) vA[d][kk] = *(const LAS bf16x8*)(vbuf + ((32 * d + r32) * AT_VLD + 16 * kk + 8 * hi) * 2);
#pragma unroll
    for (int kk = 0; kk < 2; ++kk)
#pragma unroll
        for (int d = 0; d < 2; ++d) vB[d][kk] = *(const LAS bf16x8*)(vbuf + ((32 * d + r32) * AT_VLD + 32 + 16 * kk + 8 * hi) * 2);
#pragma unroll
    for (int kk = 0; kk < 2; ++kk)
#pragma unroll
        for (int d = 0; d < 2; ++d) o[d] = __builtin_amdgcn_mfma_f32_32x32x16_bf16(vA[d][kk], pf[0][kk], o[d], 0, 0, 0);
#pragma unroll
    for (int kk = 0; kk < 2; ++kk)
#pragma unroll
        for (int d = 0; d < 2; ++d) o[d] = __builtin_amdgcn_mfma_f32_32x32x16_bf16(vB[d][kk], pf[1][kk], o[d], 0, 0, 0);
}

template <int MODE>
DI void attn_unit(const AttnArgs& a, unsigned char* smem_, int tid) {
    LAS unsigned char* smem = (LAS unsigned char*)smem_;
    constexpr int NQF = (MODE == 1) ? 6 : 4;
    constexpr bool DIST2 = false;
    const int lane = tid & 63, w = __builtin_amdgcn_readfirstlane(tid >> 6), r32 = lane & 31, hi = lane >> 5;
    constexpr bool SPLIT = false;
    const int grp = w >> 2;
    const int qw = a.q0 + 32 * w;
    const long qrow = a.row0 + qw + r32;
    bf16x8 qf[NQF];
#pragma unroll
    for (int d0 = 0; d0 < NQF; ++d0) qf[d0] = *(const GAS bf16x8*)(gptr(a.Q) + qrow * a.ldq + 16 * d0 + 8 * hi);
    int tb = 0, te = a.S / 64;
    if (MODE == 0) { const int lo = a.q0 - 128, hi_ = a.q0 + 384; tb = (lo < 0 ? 0 : lo) / 64; te = (hi_ > a.S ? a.S : hi_) / 64; }
    const int kkey = tid >> 3, kch = tid & 7;
    const GAS bf16_t* kp = gptr(a.K) + (a.row0 + kkey) * (long)a.ldk + kch * 8;
    const GAS bf16_t* k2p = gptr(a.K2) + (a.row0 + (tid >> 2)) * (long)a.ldk2 + (tid & 3) * 8;
    const GAS bf16_t* vp = gptr(a.VT) + (long)(tid >> 3) * MTOK + a.row0 + (tid & 7) * 8;
    const int kdst = (kkey * AT_KLD + kch * 8) * 2, k2dst = ((tid >> 2) * AT_KLD + 64 + (tid & 3) * 8) * 2, vdst = ((tid >> 3) * AT_VLD + 16 * ((tid & 7) >> 1) + 4 * (tid & 1)) * 2;
    u32x4 kr, k2r, vr;
    kr = *(const GAS u32x4*)(kp + (long)tb * 64 * a.ldk);
    if (MODE == 1 && tid < 256) k2r = *(const GAS u32x4*)(k2p + (long)tb * 64 * a.ldk2);
    vr = *(const GAS u32x4*)(vp + tb * 64);
    *(LAS u32x4*)(smem + kdst) = kr;
    if (MODE == 1 && tid < 256) *(LAS u32x4*)(smem + k2dst) = k2r;
    *(LAS u32x2*)(smem + AT_VOFF + vdst) = (u32x2){vr.x, vr.y}; *(LAS u32x2*)(smem + AT_VOFF + vdst + 16) = (u32x2){vr.z, vr.w};
    if (DIST2 && tb + 1 < te) {
        kr = *(const GAS u32x4*)(kp + (long)(tb + 1) * 64 * a.ldk);
        if (MODE == 1 && tid < 256) k2r = *(const GAS u32x4*)(k2p + (long)(tb + 1) * 64 * a.ldk2);
        vr = *(const GAS u32x4*)(vp + (tb + 1) * 64);
    }
    __syncthreads();
    float m0 = 0.f, l0 = 0.f, m1 = 0.f, l1 = 0.f;
    if (MODE == 0) { m0 = a.sink2; l0 = hi == 0 ? 1.f : 0.f; }
    f32x16 o0[2], o1[2], ng0, ng1, pat;
#pragma unroll
    for (int r = 0; r < 16; ++r) { ng0[r] = -m0; ng1[r] = 0.f; }
    bool flipped = false;
    if (MODE == 3) {
#pragma unroll
        for (int r = 0; r < 16; ++r) pat[r] = a.slope2 * (float)((r & 3) + 8 * (r >> 2));
    }
#pragma unroll
    for (int d = 0; d < 2; ++d)
#pragma unroll
        for (int r = 0; r < 16; ++r) { o0[d][r] = 0.f; o1[d][r] = 0.f; }
    auto step = [&](const int t, u32x4& xk, u32x4& xk2, u32x4& xv, u32x4& yk, u32x4& yk2, u32x4& yv) __attribute__((always_inline)) {
        const int cur = (t - tb) & 1;
        const bool more = (t + 1 < te);
        const bool more2 = (t + 2 < te);
        if (DIST2 ? more2 : more) {
            const int tl = t + (DIST2 ? 2 : 1);
            yk = *(const GAS u32x4*)(kp + (long)tl * 64 * a.ldk);
            if (MODE == 1 && tid < 256) yk2 = *(const GAS u32x4*)(k2p + (long)tl * 64 * a.ldk2);
            yv = *(const GAS u32x4*)(vp + tl * 64);
        }
        const LAS unsigned char* kb = smem + cur * AT_KBUF;
        const LAS unsigned char* vb = smem + AT_VOFF + cur * AT_VBUF;
        const int k0 = t * 64;
        bool active = true;
        if (MODE == 0) active = (k0 + 63 >= qw - 128) && (k0 <= qw + 31 + 128);
        if (SPLIT) {
            f32x16 sp[2];
            if (active) {
                const float dq = (float)(qw + r32 - k0 - 4 * hi);
                const bool first = (MODE != 0) && (t == tb);
                if (MODE == 0) attn_tile_x<4, 0, true, true>(qf, kb, sp, m0, ng0, l0, o0, dq, a.slope2, r32, hi, first);
                else if (MODE == 1) attn_tile_x<6, 0, false, false>(qf, kb, sp, m0, ng0, l0, o0, dq, a.slope2, r32, hi, first);
                else attn_tile_x<4, 0, false, false>(qf, kb, sp, m0, ng0, l0, o0, dq, a.slope2, r32, hi, first);
            }
            if (grp == 1 && more) {
                LAS unsigned char* nb = smem + (cur ^ 1) * AT_KBUF;
                *(LAS u32x4*)(nb + kdst) = xk;
                if (MODE == 1 && tid < 256) *(LAS u32x4*)(nb + k2dst) = xk2;
                *(LAS u32x2*)(smem + AT_VOFF + (cur ^ 1) * AT_VBUF + vdst) = (u32x2){xv.x, xv.y}; *(LAS u32x2*)(smem + AT_VOFF + (cur ^ 1) * AT_VBUF + vdst + 16) = (u32x2){xv.z, xv.w};
            }
            asm volatile("s_waitcnt lgkmcnt(0)" ::: "memory"); __builtin_amdgcn_s_barrier(); asm volatile("" ::: "memory");
            if (active) attn_tile_y(sp, vb, l0, o0, r32, hi);
            if (grp == 0 && more) {
                LAS unsigned char* nb = smem + (cur ^ 1) * AT_KBUF;
                *(LAS u32x4*)(nb + kdst) = xk;
                if (MODE == 1 && tid < 256) *(LAS u32x4*)(nb + k2dst) = xk2;
                *(LAS u32x2*)(smem + AT_VOFF + (cur ^ 1) * AT_VBUF + vdst) = (u32x2){xv.x, xv.y}; *(LAS u32x2*)(smem + AT_VOFF + (cur ^ 1) * AT_VBUF + vdst + 16) = (u32x2){xv.z, xv.w};
            }
            asm volatile("s_waitcnt lgkmcnt(0)" ::: "memory"); __builtin_amdgcn_s_barrier(); asm volatile("" ::: "memory");
            return;
        }
        if (active) {
            const float dq = (float)(qw + r32 - k0 - 4 * hi);
            const bool first = (MODE != 0) && (t == tb);
            if (MODE == 0) attn_tile<4, 0, true, true>(qf, kb, vb, m0, ng0, l0, o0, dq, a.slope2, r32, hi, first);
            else if (MODE == 1) attn_tile<6, 0, false, false>(qf, kb, vb, m0, ng0, l0, o0, dq, a.slope2, r32, hi, first);
            else if (MODE == 2) attn_tile<4, 0, false, false>(qf, kb, vb, m0, ng0, l0, o0, dq, a.slope2, r32, hi, first);
            else {
                const bool right = (k0 > qw + 31), diag = !right && !(k0 + 63 < qw);
                if (right && !flipped) {
#pragma unroll
                    for (int r = 0; r < 16; ++r) { pat[r] = -pat[r]; asm volatile("" : "+v"(pat[r])); }
                    flipped = true;
                }
                const float adj = right ? a.slope2 * dq : -a.slope2 * dq;
                const float adj32 = right ? -32.f * a.slope2 : 32.f * a.slope2;
                attn_tile_d<0>(qf, kb, vb, m0, l0, o0, pat, diag, adj, adj32, dq, a.slope2, r32, hi, first);
                __builtin_amdgcn_sched_barrier(0);
                float dq1 = dq; asm volatile("" : "+v"(dq1));
                attn_tile_d<2>(qf, kb, vb, m1, l1, o1, pat, diag, adj, adj32, dq1, a.slope2, r32, hi, first);
            }
        }
        if (more) {
            LAS unsigned char* nb = smem + (cur ^ 1) * AT_KBUF;
            *(LAS u32x4*)(nb + kdst) = xk;
            if (MODE == 1 && tid < 256) *(LAS u32x4*)(nb + k2dst) = xk2;
            *(LAS u32x2*)(smem + AT_VOFF + (cur ^ 1) * AT_VBUF + vdst) = (u32x2){xv.x, xv.y}; *(LAS u32x2*)(smem + AT_VOFF + (cur ^ 1) * AT_VBUF + vdst + 16) = (u32x2){xv.z, xv.w};
        }
        asm volatile("s_waitcnt lgkmcnt(0)" ::: "memory"); __builtin_amdgcn_s_barrier(); asm volatile("" ::: "memory");
    };
    u32x4 kn, k2n, vn;
    if (SPLIT && grp == 1) { __builtin_amdgcn_s_barrier(); asm volatile("" ::: "memory"); }
    if (DIST2) {
        for (int t = tb; t < te; t += 2) {
            step(t, kr, k2r, vr, kn, k2n, vn);
            if (t + 1 < te) step(t + 1, kn, k2n, vn, kr, k2r, vr);
        }
    } else {
        for (int t = tb; t < te; ++t) step(t, kr, k2r, vr, kr, k2r, vr);
    }
    if (SPLIT && grp == 0) { __builtin_amdgcn_s_barrier(); asm volatile("" ::: "memory"); }
    l0 += __shfl_xor(l0, 32);
    const float i0 = 1.f / l0;
    GAS bf16_t* op = gptr(a.O) + qrow * DMODEL;
    if (MODE != 3) {
#pragma unroll
        for (int d = 0; d < 2; ++d)
#pragma unroll
            for (int g4 = 0; g4 < 4; ++g4) {
                u32x2 wv; wv.x = pk2(o0[d][4 * g4] * i0, o0[d][4 * g4 + 1] * i0); wv.y = pk2(o0[d][4 * g4 + 2] * i0, o0[d][4 * g4 + 3] * i0);
                *(GAS u32x2*)(op + 32 * d + 8 * g4 + 4 * hi) = wv;
            }
    } else {
        l1 += __shfl_xor(l1, 32);
        const float i1 = a.lam / l1;
        float ss = 0.f;
#pragma unroll
        for (int d = 0; d < 2; ++d)
#pragma unroll
            for (int r = 0; r < 16; ++r) { const float v = o0[d][r] * i0 - o1[d][r] * i1; o0[d][r] = v; ss += v * v; }
        ss += __shfl_xor(ss, 32);
        const float rn = rsqrtf(ss * (1.f / 64.f) + EPS) * a.post;
#pragma unroll
        for (int d = 0; d < 2; ++d)
#pragma unroll
            for (int g4 = 0; g4 < 4; ++g4) {
                const int dd = 32 * d + 8 * g4 + 4 * hi;
                const f32x4 gn = *(const GAS f32x4*)(gptr(a.subn) + dd);
                u32x2 wv; wv.x = pk2(o0[d][4 * g4] * rn * gn[0], o0[d][4 * g4 + 1] * rn * gn[1]); wv.y = pk2(o0[d][4 * g4 + 2] * rn * gn[2], o0[d][4 * g4 + 3] * rn * gn[3]);
                *(GAS u32x2*)(op + dd) = wv;
            }
    }
}

DI void attn_pair_sm(f32x16 (&s)[2], float& mhat, float& l, f32x16 (&o)[2], bf16x8 (&pf)[2][2], const bool first) {
    float mx = s[0][0];
#pragma unroll
    for (int r = 1; r < 16; ++r) mx = fmaxf(mx, s[0][r]);
#pragma unroll
    for (int r = 0; r < 16; ++r) mx = fmaxf(mx, s[1][r]);
    mx = fmaxf(mx, __shfl_xor(mx, 32)) - mhat;
    if (first || __any(mx > 8.f)) {
        const float dl = first ? mx : fmaxf(mx, 0.f);
        mhat += dl;
        const float f = first ? 1.f : __builtin_amdgcn_exp2f(-dl);
        l *= f;
#pragma unroll
        for (int d = 0; d < 2; ++d)
#pragma unroll
            for (int r = 0; r < 16; ++r) o[d][r] *= f;
    }
    float ps = 0.f;
#pragma unroll
    for (int blk = 0; blk < 2; ++blk)
#pragma unroll
        for (int r = 0; r < 16; ++r) { const float p = __builtin_amdgcn_exp2f(s[blk][r] - mhat); s[blk][r] = p; ps += p; }
    l += ps;
#pragma unroll
    for (int blk = 0; blk < 2; ++blk)
#pragma unroll
        for (int kk = 0; kk < 2; ++kk) {
            u32x4 pw; pw.x = pk2(s[blk][8 * kk + 0], s[blk][8 * kk + 1]); pw.y = pk2(s[blk][8 * kk + 2], s[blk][8 * kk + 3]);
            pw.z = pk2(s[blk][8 * kk + 4], s[blk][8 * kk + 5]); pw.w = pk2(s[blk][8 * kk + 6], s[blk][8 * kk + 7]);
            pf[blk][kk] = __builtin_bit_cast(bf16x8, pw);
        }
}
DI void attn_unit_pairC(const AttnArgs& a, unsigned char* smem_, int tid) {
    LAS unsigned char* smem = (LAS unsigned char*)smem_;
    const int lane = tid & 63, w = __builtin_amdgcn_readfirstlane(tid >> 6), r32 = lane & 31, hi = lane >> 5;
    const int qw = a.q0 + 32 * w;
    const long qrow = a.row0 + qw + r32;
    bf16x8 qfA[4], qfB[4];
#pragma unroll
    for (int d0 = 0; d0 < 4; ++d0) { qfA[d0] = *(const GAS bf16x8*)(gptr(a.Q) + qrow * a.ldq + 16 * d0 + 8 * hi); qfB[d0] = *(const GAS bf16x8*)(gptr(a.Q) + qrow * a.ldq + 64 + 16 * d0 + 8 * hi); }
    const int tb = 0, te = a.S / 64;
    const int kkey = tid >> 3, kch = tid & 7;
    const GAS bf16_t* kp = gptr(a.K) + (a.row0 + kkey) * (long)a.ldk + kch * 8;
    const GAS bf16_t* vp = gptr(a.VT) + (long)(tid >> 3) * MTOK + a.row0 + (tid & 7) * 8;
    const int kdst = (kkey * AT_KLD + kch * 8) * 2, vdst = ((tid >> 3) * AT_VLD + 16 * ((tid & 7) >> 1) + 4 * (tid & 1)) * 2;
    u32x4 kr, vr;
    kr = *(const GAS u32x4*)(kp + (long)tb * 64 * a.ldk);
    vr = *(const GAS u32x4*)(vp + tb * 64);
    *(LAS u32x4*)(smem + kdst) = kr;
    *(LAS u32x2*)(smem + AT_VOFF + vdst) = (u32x2){vr.x, vr.y}; *(LAS u32x2*)(smem + AT_VOFF + vdst + 16) = (u32x2){vr.z, vr.w};
    __syncthreads();
    float mA = 0.f, lA = 0.f, mB = 0.f, lB = 0.f;
    f32x16 oA[2], oB[2];
#pragma unroll
    for (int d = 0; d < 2; ++d)
#pragma unroll
        for (int r = 0; r < 16; ++r) { oA[d][r] = 0.f; oB[d][r] = 0.f; }
    const f32x16 zero16 = {0.f, 0.f, 0.f, 0.f, 0.f, 0.f, 0.f, 0.f, 0.f, 0.f, 0.f, 0.f, 0.f, 0.f, 0.f, 0.f};
    for (int t = tb; t < te; ++t) {
        const int cur = (t - tb) & 1;
        const bool more = (t + 1 < te);
        if (more) { kr = *(const GAS u32x4*)(kp + (long)(t + 1) * 64 * a.ldk); vr = *(const GAS u32x4*)(vp + (t + 1) * 64); }
        const LAS unsigned char* kb = smem + cur * AT_KBUF;
        const LAS unsigned char* vb = smem + AT_VOFF + cur * AT_VBUF;
        const bool first = (t == tb);
        f32x16 sA[2], sB[2];
        {
            bf16x8 kf[2][4];
#pragma unroll
            for (int d0 = 0; d0 < 4; ++d0)
#pragma unroll
                for (int blk = 0; blk < 2; ++blk) kf[blk][d0] = *(const LAS bf16x8*)(kb + ((32 * blk + r32) * AT_KLD + 16 * d0 + 8 * hi) * 2);
#pragma unroll
            for (int d0 = 0; d0 < 4; ++d0)
#pragma unroll
                for (int blk = 0; blk < 2; ++blk) {
                    sA[blk] = __builtin_amdgcn_mfma_f32_32x32x16_bf16(kf[blk][d0], qfA[d0], d0 == 0 ? zero16 : sA[blk], 0, 0, 0);
                    sB[blk] = __builtin_amdgcn_mfma_f32_32x32x16_bf16(kf[blk][d0], qfB[d0], d0 == 0 ? zero16 : sB[blk], 0, 0, 0);
                }
        }
        bf16x8 pfA[2][2], pfB[2][2];
        attn_pair_sm(sA, mA, lA, oA, pfA, first);
        attn_pair_sm(sB, mB, lB, oB, pfB, first);
#pragma unroll
        for (int blk = 0; blk < 2; ++blk) {
            bf16x8 vf[2][2];
#pragma unroll
            for (int kk = 0; kk < 2; ++kk)
#pragma unroll
                for (int d = 0; d < 2; ++d) vf[kk][d] = *(const LAS bf16x8*)(vb + ((32 * d + r32) * AT_VLD + 32 * blk + 16 * kk + 8 * hi) * 2);
#pragma unroll
            for (int kk = 0; kk < 2; ++kk)
#pragma unroll
                for (int d = 0; d < 2; ++d) {
                    oA[d] = __builtin_amdgcn_mfma_f32_32x32x16_bf16(vf[kk][d], pfA[blk][kk], oA[d], 0, 0, 0);
                    oB[d] = __builtin_amdgcn_mfma_f32_32x32x16_bf16(vf[kk][d], pfB[blk][kk], oB[d], 0, 0, 0);
                }
        }
        if (more) {
            LAS unsigned char* nb = smem + (cur ^ 1) * AT_KBUF;
            *(LAS u32x4*)(nb + kdst) = kr;
            *(LAS u32x2*)(smem + AT_VOFF + (cur ^ 1) * AT_VBUF + vdst) = (u32x2){vr.x, vr.y}; *(LAS u32x2*)(smem + AT_VOFF + (cur ^ 1) * AT_VBUF + vdst + 16) = (u32x2){vr.z, vr.w};
        }
        asm volatile("s_waitcnt lgkmcnt(0)" ::: "memory"); __builtin_amdgcn_s_barrier(); asm volatile("" ::: "memory");
    }
    lA += __shfl_xor(lA, 32); lB += __shfl_xor(lB, 32);
    const float iA = 1.f / lA, iB = 1.f / lB;
    GAS bf16_t* op = gptr(a.O) + qrow * DMODEL;
#pragma unroll
    for (int d = 0; d < 2; ++d)
#pragma unroll
        for (int g4 = 0; g4 < 4; ++g4) {
            u32x2 wa, wb;
            wa.x = pk2(oA[d][4 * g4] * iA, oA[d][4 * g4 + 1] * iA); wa.y = pk2(oA[d][4 * g4 + 2] * iA, oA[d][4 * g4 + 3] * iA);
            wb.x = pk2(oB[d][4 * g4] * iB, oB[d][4 * g4 + 1] * iB); wb.y = pk2(oB[d][4 * g4 + 2] * iB, oB[d][4 * g4 + 3] * iB);
            *(GAS u32x2*)(op + 32 * d + 8 * g4 + 4 * hi) = wa;
            *(GAS u32x2*)(op + 64 + 32 * d + 8 * g4 + 4 * hi) = wb;
        }
}

template <class ColMap, class Scale>
DI void wprep(const float* __restrict__ src, int ldsrc, int K, bf16_t* dst, int ndst, const float* __restrict__ gain, ColMap cm, Scale sc, LAS float* scr, int gw, int ngw, int lane, int& ibase) {
    const int nblk = ndst / 32, nitems = (K / 64) * nblk;
    const int first = (gw + ngw - (ibase % ngw)) % ngw;
    ibase += nitems;
    for (int it = first; it < nitems; it += ngw) {
        const int kb = it / nblk, nb = it - kb * nblk, k0 = 64 * kb, n0 = 32 * nb;
        const int c = cm(n0 + (lane & 31)); const float sv = sc(n0 + (lane & 31));
        float wv[32];
#pragma unroll
        for (int i = 0; i < 32; ++i) { const int k = k0 + 2 * i + (lane >> 5); wv[i] = c >= 0 ? src[(long)k * ldsrc + c] : 0.f; }
#pragma unroll
        for (int i = 0; i < 32; ++i) {
            const int kk = 2 * i + (lane >> 5), k = k0 + kk;
            scr[kk * 33 + (lane & 31)] = wv[i] * (gain ? gain[k] : 1.f) * sv;
        }
        const int c8 = lane & 7;
#pragma unroll
        for (int j = 0; j < 4; ++j) {
            const int n = (lane >> 3) + 8 * j; const LAS float* q = scr + (8 * c8) * 33 + n;
            u32x4 o; o.x = pk2(q[0], q[33]); o.y = pk2(q[2 * 33], q[3 * 33]); o.z = pk2(q[4 * 33], q[5 * 33]); o.w = pk2(q[6 * 33], q[7 * 33]);
            *(u32x4*)(dst + (long)(n0 + n) * K + k0 + 8 * c8) = o;
        }
        asm volatile("s_waitcnt lgkmcnt(0)" ::: "memory");
    }
}

DI int in_colmap(int n) {
    if (n < 256) return n;
    if (n < 384) return 256 + (n - 256);
    if (n < 512) return 1184 + (n - 384);
    if (n < 768) return 512 + (n - 512);
    if (n < 896) return 768 + (n - 768);
    if (n < 928) return 896 + (n - 896);
    if (n < 1024) return -1;
    if (n < 1280) return 928 + (n - 1024);
    if (n < 1536) return 1440 + (n - 1280);
    if (n < 1792) return 1696 + (n - 1536);
    if (n < 1920) return 384 + (n - 1792);
    if (n < 2048) return 1312 + (n - 1920);
    return 1952 + (n - 2048);
}

DI const float* inptr(const Params& p, int i) { asm volatile("" : "+s"(i)); return p.in[i]; }
#define XB_TMO      128
#define XB_XCNT(j)  (256  + 64 * (j))
#define XB_XSUB(j)  (1280 + 64 * (j))
#define XB_XGEN(j)  (2304 + 64 * (j))
#define XB_TOP      3328
#define XB_TOPGEN   3392
#define XCD_BAR_WORDS 3456
#define XB_SPIN_CAP (1u << 18)

__device__ __forceinline__ unsigned xb_ld(unsigned* p)              { return __hip_atomic_load(p, __ATOMIC_RELAXED, __HIP_MEMORY_SCOPE_AGENT); }
__device__ __forceinline__ unsigned xb_add(unsigned* p, unsigned v) { return __hip_atomic_fetch_add(p, v, __ATOMIC_RELAXED, __HIP_MEMORY_SCOPE_AGENT); }
__device__ __forceinline__ unsigned xb_xcc_id() { return (unsigned)__builtin_amdgcn_s_getreg((3 << 11) | 20) & 0xFu; }
#define XB_SPIN(cond, bar) do { unsigned _sp = 0; while (cond) { __builtin_amdgcn_s_sleep(1); \
    if ((++_sp & 255u) == 0u) { if (xb_ld(&(bar)[XB_TMO])) break; if (_sp > XB_SPIN_CAP) { atomicAdd(&(bar)[XB_TMO], 1u); break; } } } } while (0)

struct XcdBarrier {
    unsigned* bar; unsigned x;
    volatile LAS unsigned* st;
};

__device__ __forceinline__ XcdBarrier xcd_barrier_post(unsigned* bar, volatile LAS unsigned* st, int wid) {
    XcdBarrier b; b.bar = bar; b.x = xb_xcc_id(); b.st = st;
    if (wid == 0 && lane_id() == 0) (void)xb_add(&bar[XB_XCNT(b.x)], 1u);
    return b;
}
__device__ __forceinline__ void xcd_barrier_complete(unsigned* bar, unsigned x, unsigned& nloc, unsigned& nx) {
    const unsigned G = gridDim.x * gridDim.y * gridDim.z;
    unsigned sum, cnt, mine, sp = 0u;
    for (;;) {
        sum = 0u; cnt = 0u; mine = 0u;
#pragma unroll
        for (unsigned j = 0; j < 16; ++j) { const unsigned c = xb_ld(&bar[XB_XCNT(j)]); sum += c; cnt += (c > 0u) ? 1u : 0u; mine = (j == x) ? c : mine; }
        if (sum == G) break;
        __builtin_amdgcn_s_sleep(1);
        if ((++sp & 255u) == 0u) { if (xb_ld(&bar[XB_TMO])) break; if (sp > XB_SPIN_CAP) { atomicAdd(&bar[XB_TMO], 1u); break; } }
    }
    nloc = mine > 0u ? mine : 1u; nx = cnt > 0u ? cnt : 1u;
}

__device__ __forceinline__ void xcd_barrier(const XcdBarrier& b, int wid) {
    asm volatile("s_waitcnt vmcnt(0)" ::: "memory");
    __syncthreads();
    if (wid == 0 && lane_id() == 0) {
        unsigned* bar = b.bar;
        __builtin_amdgcn_s_waitcnt(0);
        unsigned nloc = b.st[0], nx = b.st[1];
        if (nloc == 0u) { xcd_barrier_complete(bar, b.x, nloc, nx); b.st[0] = nloc; b.st[1] = nx; }
        const unsigned old = xb_add(&bar[XB_XSUB(b.x)], 1u);
        const unsigned gen = old / nloc;
        if (old + 1u == (gen + 1u) * nloc) {
            __builtin_amdgcn_fence(__ATOMIC_RELEASE, "agent");
            asm volatile("s_waitcnt vmcnt(0)" ::: "memory");
            const unsigned og = xb_add(&bar[XB_TOP], 1u);
            const unsigned tg = og / nx;
            if (og + 1u == (tg + 1u) * nx) xb_add(&bar[XB_TOPGEN], 1u);
            else XB_SPIN(xb_ld(&bar[XB_TOPGEN]) == tg, bar);
            __builtin_amdgcn_fence(__ATOMIC_ACQUIRE, "agent");
            xb_add(&bar[XB_XGEN(b.x)], 1u);
            asm volatile("s_waitcnt vmcnt(0)" ::: "memory");
        } else {
            XB_SPIN(xb_ld(&bar[XB_XGEN(b.x)]) == gen, bar);
            __builtin_amdgcn_fence(__ATOMIC_ACQUIRE, "agent");
            asm volatile("s_waitcnt vmcnt(0)" ::: "memory");
        }
    }
    __syncthreads();
}
DI void grid_barrier(unsigned* ctr, unsigned target, int wid) {
    __threadfence();
    __syncthreads();
    if (wid == 0 && lane_id() == 0) {
        __hip_atomic_fetch_add(ctr, 1u, __ATOMIC_RELEASE, __HIP_MEMORY_SCOPE_AGENT);
        unsigned spins = 0;
        while (__hip_atomic_load(ctr, __ATOMIC_ACQUIRE, __HIP_MEMORY_SCOPE_AGENT) < target) { __builtin_amdgcn_s_sleep(4); if (++spins > (1u << 24)) break; }
    }
    __syncthreads();
    __threadfence();
}

template <int PH>
DI void run_phase(const Params& p, const int wid, unsigned char* smem) {
    constexpr int ph = PH;
    const int wr = wid >> 2, wc = wid & 3;
    const int nblk = gridDim.x, bid = blockIdx.x;
    const long gthreads = (long)nblk * NTHREADS;
    const int gw = bid * 8 + wid, ngw = nblk * 8;
        const int lane = lane_id(), tid = wid * 64 + lane;
        unsigned char* ws = p.ws; asm volatile("" : "+s"(ws));
            float* pout = p.out; asm volatile("" : "+s"(pout));
        unsigned* ctl = (unsigned*)(ws + WS_CTL);
        float* stat = (float*)(ws + WS_STAT);
        float* rope = (float*)(ws + WS_ROPE);
        bf16_t* H = (bf16_t*)(ws + WS_H); bf16_t* VT = (bf16_t*)(ws + WS_VT); bf16_t* Gb = (bf16_t*)(ws + WS_G);
        bf16_t* XB = (bf16_t*)(ws + WS_XB); bf16_t* QB = (bf16_t*)(ws + WS_QB); bf16_t* KBN = (bf16_t*)(ws + WS_KBN); bf16_t* ATT = (bf16_t*)(ws + WS_ATT);
        const long gtid = (long)bid * NTHREADS + tid;
        if (ph == 0 && (SUBMASK & 0x100)) {
            for (long i = gtid; i < 5L * MTOK; i += gthreads) stat[MTOK + i] = 0.f;
            for (long i = gtid; i < 4096L * 16; i += gthreads) {
                const int pos = (int)(i >> 4), k = (int)(i & 15);
                const float inv = exp2f(-(float)k * (13.287712379549449f / 16.f));
                float sn, cs; sincosf((float)pos * inv, &sn, &cs);
                rope[2 * i] = cs; rope[2 * i + 1] = sn;
            }
            {
                const float* xin0 = inptr(p, 0); const float* xin1 = inptr(p, 1);
                for (int row0 = gw; row0 < MTOK; row0 += 8 * ngw) {
                    f32x4 va[8][4];
#pragma unroll
                    for (int q = 0; q < 8; ++q) {
                        const int row = row0 + q * ngw;
                        if (row < MTOK) {
                            const GAS float* xr = row < MPROMPT ? gptr(xin0) + (long)row * DMODEL : gptr(xin1) + (long)(row - MPROMPT) * DMODEL;
#pragma unroll
                            for (int j = 0; j < 2; ++j) { va[q][2 * j] = *(const GAS f32x4*)(xr + 512 * j + 8 * lane); va[q][2 * j + 1] = *(const GAS f32x4*)(xr + 512 * j + 8 * lane + 4); }
                        }
                    }
#pragma unroll
                    for (int q = 0; q < 8; ++q) {
                        const int row = row0 + q * ngw;
                        if (row < MTOK) {
                            float ss = 0.f;
#pragma unroll
                            for (int j = 0; j < 2; ++j) {
                                const f32x4 a = va[q][2 * j], b = va[q][2 * j + 1];
                                ss += (a[0] * a[0] + a[1] * a[1]) + (a[2] * a[2] + a[3] * a[3]) + (b[0] * b[0] + b[1] * b[1]) + (b[2] * b[2] + b[3] * b[3]);
                                u32x4 w; w.x = pk2(a[0], a[1]); w.y = pk2(a[2], a[3]); w.z = pk2(b[0], b[1]); w.w = pk2(b[2], b[3]);
                                *(GAS u32x4*)(gptr(XB) + (long)row * DMODEL + 512 * j + 8 * lane) = w;
                            }
#pragma unroll
                            for (int o = 1; o < 64; o <<= 1) ss += __shfl_xor(ss, o);
                            if (lane == 0) stat[ST_ATTN0 * MTOK + row] = ss;
                        }
                    }
                }
            }
            LAS float* scr = (LAS float*)((LAS unsigned char*)smem + wid * 8448);
            int ibase = 0;
            for (int l = 0; l < 2; ++l) {
                unsigned char* wl = ws + WS_W + l * WL_STRIDE;
                wprep(inptr(p, 3) + (long)l * DMODEL * INW, INW, DMODEL, (bf16_t*)(wl + WL_IN), 2304, inptr(p, 2) + l * DMODEL, [](int n) { return in_colmap(n); },
                      [](int n) { return n < 256 ? 0.125f * LOG2E : ((n >= 1280 && n < 1536) ? 0.17677669529663687f * LOG2E : 1.f); }, scr, gw, ngw, lane, ibase);
                wprep(inptr(p, 6) + (long)l * 256 * 384, 384, 256, (bf16_t*)(wl + WL_QUP), 512, inptr(p, 5) + l * 256,
                      [](int s) { if (s >= 384) return -1; const int h = s / 96, w = s % 96; if (w < 64) return h * 96 + w; const int g = (w - 64) >> 3, e = (w - 64) & 7; return h * 96 + 64 + (e < 4 ? 4 * g + e : 16 + 4 * g + (e - 4)); },
                      [](int) { return 0.10206207261596575f * LOG2E; }, scr, gw, ngw, lane, ibase);
                wprep(inptr(p, 8) + (long)l * 128 * 512, 512, 128, (bf16_t*)(wl + WL_KUP), 256, inptr(p, 7) + l * 128, [](int n) { return (n >> 6) * 128 + (n & 63); }, [](int) { return 1.f; }, scr, gw, ngw, lane, ibase);
                wprep(inptr(p, 8) + (long)l * 128 * 512, 512, 128, (bf16_t*)(wl + WL_VUP), 256, inptr(p, 7) + l * 128, [](int n) { return (n >> 6) * 128 + 64 + (n & 63); }, [](int) { return 1.f; }, scr, gw, ngw, lane, ibase);
                wprep(inptr(p, 16) + (long)l * DMODEL * DMODEL, DMODEL, DMODEL, (bf16_t*)(wl + WL_OUT), 1024, nullptr, [](int n) { return n; }, [](int) { return 1.f; }, scr, gw, ngw, lane, ibase);
                wprep(inptr(p, 18) + (long)l * DMODEL * DFF2, DFF2, DMODEL, (bf16_t*)(wl + WL_UP), DFF2, inptr(p, 17) + l * DMODEL,
                      [](int n) { const int pn = n >> 8, r = n & 255; return (r >> 7) * DFF + 128 * pn + (r & 127); }, [](int) { return 1.f; }, scr, gw, ngw, lane, ibase);
                wprep(inptr(p, 22) + (long)l * DFF * DMODEL, DMODEL, DFF, (bf16_t*)(wl + WL_DOWN), 1024, nullptr, [](int n) { return n; }, [](int) { return 1.f; }, scr, gw, ngw, lane, ibase);
            }
            for (long i = gtid; i < 2L * DFF; i += gthreads) {
                const int l = (int)(i / DFF), ff = (int)(i % DFF);
                const float* cw = inptr(p, 20) + (long)l * 3 * DFF2; const float* cb = inptr(p, 21) + (long)l * DFF2;
                float* o = (float*)(ws + WS_CP) + i * 8;
                o[0] = cw[ff]; o[1] = cw[DFF2 + ff]; o[2] = cw[2 * DFF2 + ff]; o[3] = cb[ff];
                o[4] = cw[DFF + ff]; o[5] = cw[DFF2 + DFF + ff]; o[6] = cw[2 * DFF2 + DFF + ff]; o[7] = cb[DFF + ff];
            }
            if (gtid < 2) {
                const int l = (int)gtid;
                float s1 = 0.f, s2 = 0.f;
                for (int i = 0; i < 32; ++i) { s1 += inptr(p, 11)[l * 32 + i] * inptr(p, 12)[l * 32 + i]; s2 += inptr(p, 13)[l * 32 + i] * inptr(p, 14)[l * 32 + i]; }
                const float lam_init = 0.8f - 0.6f * expf(-0.3f * (float)l);
                ((float*)ctl)[CW_LAM + l] = expf(s1) - expf(s2) + lam_init;
            }
        } else if (ph == NPHASES - 1 && (SUBMASK & 0x200)) {
            const float* gf = inptr(p, 23);
            f32x4 gv[4];
#pragma unroll
            for (int j = 0; j < 4; ++j) gv[j] = *(const f32x4*)(gf + 256 * j + 4 * lane);
            for (int row0 = gw; row0 < MTOK; row0 += 8 * ngw) {
                f32x4 v[8][4];
#pragma unroll
                for (int q = 0; q < 8; ++q) {
                    const int row = row0 + q * ngw;
                    if (row < MTOK) {
#pragma unroll
                        for (int j = 0; j < 4; ++j) v[q][j] = *(const GAS f32x4*)(gptr(pout) + (long)row * DMODEL + 256 * j + 4 * lane);
                    }
                }
#pragma unroll
                for (int q = 0; q < 8; ++q) {
                    const int row = row0 + q * ngw;
                    if (row < MTOK) {
                        float ss = 0.f;
#pragma unroll
                        for (int j = 0; j < 4; ++j) ss += (v[q][j][0] * v[q][j][0] + v[q][j][1] * v[q][j][1]) + (v[q][j][2] * v[q][j][2] + v[q][j][3] * v[q][j][3]);
#pragma unroll
                        for (int o = 1; o < 64; o <<= 1) ss += __shfl_xor(ss, o);
                        const float rs = rsqrtf(ss * (1.f / 1024.f) + EPS);
#pragma unroll
                        for (int j = 0; j < 4; ++j) *(GAS f32x4*)(gptr(pout) + (long)row * DMODEL + 256 * j + 4 * lane) = v[q][j] * rs * gv[j];
                    }
                }
            }
        } else {
            const int l = (ph - 1) / 7, sub = (ph - 1) % 7;
            unsigned char* wl = ws + WS_W + l * WL_STRIDE;
            const float* rs_attn = stat + (l == 0 ? ST_ATTN0 : ST_ATTN1) * MTOK;
            float* rs_ffn = stat + (l == 0 ? ST_FFN0 : ST_FFN1) * MTOK;
            float* sqq = stat + ST_SQQ * MTOK; float* sqkv = stat + ST_SQKV * MTOK;
            PG8_LAS unsigned char* lds3 = (PG8_LAS unsigned char*)smem;
            if (sub == 0 && (SUBMASK & 1)) {
                SchedInproj S; S.o.init(192, 9); S.XB = (const char*)XB; S.W = (const char*)(wl + WL_IN);
                EpiInproj E{EpiScaleStore<0>{H, HW, rs_attn, 1.f / 1024.f, HW, sqq, sqkv}, EpiScaleStore<1>{VT, MTOK, rs_attn, 1.f / 1024.f, MTOK, nullptr, nullptr}};
                pg8::gemm_phase<false>(lds3, wid, DMODEL, DMODEL, DMODEL, S, E); if (PROBE_GEMM > 1) pg8::gemm_phase<false>(lds3, wid, DMODEL, DMODEL, DMODEL, S, E);
            } else if (sub == 2 && (SUBMASK & 4)) {
                const float* gq = inptr(p, 9) + l * 64; const float* gk = inptr(p, 10) + l * 64;
                int col = -1, kind = 0;
                if (lane < 32) { col = 1024 + 8 * lane; kind = 1; } else if (lane < 48) { col = 384 + 8 * (lane - 32); kind = 2; } else if (lane < 52) { col = 896 + 8 * (lane - 48); kind = 3; }
                auto proc = [&](const int row, const u32x4 raw, const u32x4 r2) __attribute__((always_inline)) {
                    bf16_t* hr = H + (long)row * HW;
                    const int pos = tok_pos(row);
                    float y[8];
                    y[0] = bflo(raw.x); y[1] = bfhi(raw.x); y[2] = bflo(raw.y); y[3] = bfhi(raw.y); y[4] = bflo(raw.z); y[5] = bfhi(raw.z); y[6] = bflo(raw.w); y[7] = bfhi(raw.w);
                    float ss = 0.f;
#pragma unroll
                    for (int e = 0; e < 8; ++e) ss += y[e] * y[e];
                    ss += __shfl_xor(ss, 1); ss += __shfl_xor(ss, 2); ss += __shfl_xor(ss, 4);
                    const int j = lane & 7;
                    if (kind == 1 || kind == 2) {
                        const float rs = rsqrtf(ss * (1.f / 64.f) + EPS) * (kind == 1 ? 0.125f * LOG2E : 1.f);
                        const float* gg = (kind == 1 ? gq : gk) + 8 * j;
#pragma unroll
                        for (int e = 0; e < 8; ++e) y[e] = y[e] * rs * gg[e];
                    }
                    const int rp = (kind == 3) ? pos : ((j < 4) ? (pos >> 6) : (pos & 63));
                    const bool isx2 = (j & 2) != 0;
                    const float* tb = rope + ((long)rp * 16 + 8 * (j & 1)) * 2;
#pragma unroll
                    for (int e = 0; e < 8; ++e) {
                        const float pvv = __shfl_xor(y[e], 2);
                        const float c = tb[2 * e], s = tb[2 * e + 1];
                        y[e] = isx2 ? (y[e] * c + pvv * s) : (y[e] * c - pvv * s);
                    }
                    if (kind) { u32x4 o; o.x = pk2(y[0], y[1]); o.y = pk2(y[2], y[3]); o.z = pk2(y[4], y[5]); o.w = pk2(y[6], y[7]); *(u32x4*)(hr + col) = o; }
                };
                const u32x4 zero4 = (u32x4){0u, 0u, 0u, 0u};
                for (int row0 = gw; row0 < MTOK; row0 += 8 * ngw) {
                    u32x4 raw[8], r2[8];
#pragma unroll
                    for (int q = 0; q < 8; ++q) {
                        const int row = row0 + q * ngw; raw[q] = zero4; r2[q] = zero4;
                        if (row < MTOK) {
                            const GAS bf16_t* hr = gptr(H) + (long)row * HW;
                            if (kind) raw[q] = *(const GAS u32x4*)(hr + col);
                        }
                    }
#pragma unroll
                    for (int q = 0; q < 8; ++q) { const int row = row0 + q * ngw; if (row < MTOK) proc(row, raw[q], r2[q]); }
                }
                {
                    SchedStd S; S.o.init(192, 2); S.A = (const char*)(H + 512); S.B = (const char*)(wl + WL_QUP); S.astride = 256L * HW * 2; S.bstride = 256L * 256 * 2;
                    EpiQup E{QB, sqq, rope};
                    pg8::gemm_phase<false>(lds3, wid, 256, HW, 256, S, E);
                }
                {
                    SchedStd S; S.o.init(192, 1); S.A = (const char*)(H + 768); S.B = (const char*)(wl + WL_KUP); S.astride = 256L * HW * 2; S.bstride = 0;
                    EpiScaleStore<0> E{KBN, 256, sqkv, 1.f / 128.f, 256, nullptr, nullptr};
                    pg8::gemm_phase<false>(lds3, wid, 128, HW, 128, S, E);
                }
                {
                    SchedStd S; S.o.init(1, 192); S.A = (const char*)(wl + WL_VUP); S.B = (const char*)(H + 768); S.astride = 0; S.bstride = 256L * HW * 2;
                    EpiScaleStore<1> E{VT + 512L * MTOK, MTOK, sqkv, 1.f / 128.f, MTOK, nullptr, nullptr};
                    pg8::gemm_phase<false>(lds3, wid, 128, 128, HW, S, E);
                }
            } else if (sub == 3 && (SUBMASK & 8)) {
                if (l == 0) { for (long i = gtid; i < 2L * MTOK; i += gthreads) stat[(long)ST_SQQ * MTOK + i] = 0.f; }
                int* sh_u = (int*)(smem + LDS_MISC);
                const float lam = ((const float*)ctl)[CW_LAM + l];
                const float lam_init = 0.8f - 0.6f * expf(-0.3f * (float)l);
#define ATTN_QUEUE(QI, NUNITS, NP, BODY) \
                for (;;) { \
                      \
                    if (wid == 0) { \
                        const int ln_ = lane_id(); \
                        unsigned* cb_ = ctl + CW_ATTN_CTR + 1024 * rep + 64 * (4 * l + QI); \
                        const unsigned c_ = (ln_ < 8) ? __hip_atomic_load(cb_ + ((myx + ln_) & 7), __ATOMIC_RELAXED, __HIP_MEMORY_SCOPE_AGENT) : (unsigned)(NUNITS); \
                        const unsigned long long m_ = __ballot(c_ < (unsigned)(NUNITS)); \
                        int res_ = -1; \
                        if (m_) { const int x_ = (myx + (__ffsll((long long)m_) - 1)) & 7; \
                            unsigned u_ = 0u; if (ln_ == 0) u_ = atomicAdd(cb_ + x_, 1u); u_ = (unsigned)__shfl((int)u_, 0); \
                            res_ = (u_ < (unsigned)(NUNITS)) ? ((x_ << 8) | (int)u_) : -2; } \
                        if (ln_ == 0) *sh_u = res_; \
                    } \
                    __syncthreads(); \
                    const int r_ = *sh_u; \
                    __syncthreads(); \
                    if (r_ == -1) break; \
                    if (r_ == -2) continue; \
                    const int xcd = r_ >> 8, u = r_ & 255; \
                    int h, qb, S; long row0; \
                      \
                    if (u < (NP)) { const int ix = (u >> 4) * 8 + xcd; h = ((NUNITS) == 96) ? (ix & 3) : 2 * (ix & 1); qb = u & 15; row0 = (long)(((NUNITS) == 96) ? (ix >> 2) : (ix >> 1)) * SEQP; S = SEQP; } \
                    else { const int v = u - (NP); const int ix = (v >> 3) * 8 + xcd; h = ((NUNITS) == 96) ? (ix & 3) : 2 * (ix & 1); qb = v & 7; row0 = MPROMPT + (long)(((NUNITS) == 96) ? (ix >> 2) : (ix >> 1)) * SEQS; S = SEQS; } \
                    AttnArgs a; \
                    a.row0 = row0; a.S = S; a.q0 = qb * 256; a.K2 = H; a.ldk2 = 0; a.sink2 = 0.f; a.lam = 0.f; a.post = 0.f; a.subn = inptr(p, 15); a.slope2 = 0.f; \
                    BODY \
                }
                const int myx = (int)(xb_xcc_id() & 7u);
                for (int rep = 0; rep < PROBE_ATTN; ++rep) {
                if ((ATMODE & 8) && (rep == 0 || (PROBE_WHICH & 8))) ATTN_QUEUE(0, 96, 64, {
                    a.Q = H + 1280 + h * 64; a.ldq = HW; a.K = H + 1536 + h * 64; a.ldk = HW; a.VT = VT + (long)(256 + h * 64) * MTOK; a.O = ATT + 768 + h * 64;
                    a.slope2 = exp2f(-(float)(h + 5)) * LOG2E; a.lam = lam; a.post = 1.f - lam_init; a.subn = inptr(p, 15) + l * 64;
                    attn_unit<3>(a, smem, wid * 64 + lane_id()); })
                if ((ATMODE & 2) && (rep == 0 || (PROBE_WHICH & 2))) ATTN_QUEUE(1, 96, 64, {
                    a.Q = QB + h * 96; a.ldq = 384; a.K = KBN + h * 64; a.ldk = 256; a.K2 = H + 896; a.ldk2 = HW; a.VT = VT + (long)(512 + h * 64) * MTOK; a.O = ATT + 256 + h * 64;
                    attn_unit<1>(a, smem, wid * 64 + lane_id()); })
                if ((ATMODE & 4) && (rep == 0 || (PROBE_WHICH & 4))) ATTN_QUEUE(2, 48, 32, {
                    a.Q = H + 1024 + h * 64; a.ldq = HW; a.K = H + 384 + (h >> 1) * 64; a.ldk = HW; a.VT = VT + (long)(128 + (h >> 1) * 64) * MTOK; a.O = ATT + 512 + h * 64;
                    attn_unit_pairC(a, smem, wid * 64 + lane_id()); })
                if ((ATMODE & 1) && (rep == 0 || (PROBE_WHICH & 1))) ATTN_QUEUE(3, 96, 64, {
                    a.Q = H + h * 64; a.ldq = HW; a.K = H + 256 + (h >> 1) * 64; a.ldk = HW; a.VT = VT + (long)((h >> 1) * 64) * MTOK; a.O = ATT + h * 64;
                    a.slope2 = exp2f(-(float)(h + 1)) * LOG2E; a.sink2 = inptr(p, 4)[l * 4 + h] * LOG2E;
                    attn_unit<0>(a, smem, wid * 64 + lane_id()); })
                }
#undef ATTN_QUEUE
            } else if (sub == 4 && (SUBMASK & 16)) {
                EpiResid E{l == 0 ? inptr(p, 0) : pout, l == 0 ? inptr(p, 1) : pout + (long)MPROMPT * DMODEL, pout, XB, rs_ffn};
                SchedStd S; S.o.init(192, 4); S.A = (const char*)ATT; S.B = (const char*)(wl + WL_OUT); S.astride = 256L * DMODEL * 2; S.bstride = 256L * DMODEL * 2;
                pg8::gemm_phase<false>(lds3, wid, DMODEL, DMODEL, DMODEL, S, E);
            } else if (sub == 5 && (SUBMASK & 32)) {
                EpiConvGate E{Gb, rs_ffn, inptr(p, 19) + (long)l * DFF2, (const float*)(ws + WS_CP) + (long)l * DFF * 8, (float*)(smem + LDS_XCH)};
                SchedStd S; S.o.init(194, 22); S.A = (const char*)(XB - DMODEL); S.B = (const char*)(wl + WL_UP); S.astride = 254L * DMODEL * 2; S.bstride = 256L * DMODEL * 2;
                pg8::gemm_phase<true>(lds3, wid, DMODEL, DMODEL, DMODEL, S, E); if (PROBE_GEMM > 1) pg8::gemm_phase<true>(lds3, wid, DMODEL, DMODEL, DMODEL, S, E);
            } else if (sub == 6 && (SUBMASK & 64)) {
                EpiResid E{pout, pout + (long)MPROMPT * DMODEL, pout, XB, l == 0 ? stat + ST_ATTN1 * MTOK : nullptr};
                SchedStd S; S.o.init(192, 4); S.A = (const char*)Gb; S.B = (const char*)(wl + WL_DOWN); S.astride = 256L * DFF * 2; S.bstride = 256L * DFF * 2;
                pg8::gemm_phase<false>(lds3, wid, DFF, DFF, DFF, S, E);
            }
        }
}

__global__ void __launch_bounds__(NTHREADS) fwd_kernel(Params p) {
    extern __shared__ __attribute__((aligned(16))) unsigned char smem[];
    const int wid = __builtin_amdgcn_readfirstlane((int)(threadIdx.x >> 6));
    const int lo = p.ph_lo, hi = p.ph_hi;
    if (lo < -5) cg::this_grid().sync();
    { volatile LAS unsigned* st0 = (volatile LAS unsigned*)((LAS unsigned char*)smem + LDS_MISC + 16); if (wid == 0 && lane_id() < 4) st0[lane_id()] = 0u; }
    __syncthreads();
    const XcdBarrier xbar = xcd_barrier_post((unsigned*)(p.ws + WS_CTL) + CW_XBAR, (volatile LAS unsigned*)((LAS unsigned char*)smem + LDS_MISC + 16), wid);
#define RUN(k) if (lo <= (k) && (k) < hi && (k) != 2 && (k) != 9) { run_phase<k>(p, wid, smem); if ((k) == 0 && PROBE_P0 > 1) run_phase<k>(p, wid, smem); if ((k) + 1 < hi) { for (int r_ = 0; r_ < PROBE_BAR; ++r_) xcd_barrier(xbar, wid); } }
    RUN(0) RUN(1) RUN(2) RUN(3) RUN(4) RUN(5) RUN(6) RUN(7) RUN(8) RUN(9) RUN(10) RUN(11) RUN(12) RUN(13) RUN(14) RUN(15)
#undef RUN
}

extern "C" void kernel_launch(void* const* d_in, const int* in_sizes, int n_in, void* d_out, int out_size, void* d_ws, size_t ws_size, hipStream_t stream) {
    static int grid = 0;
    if (grid == 0) {
        if (n_in != 24 || out_size != MTOK * DMODEL || ws_size < WS_END) { fprintf(stderr, "kernel_launch: unexpected shapes (n_in %d out %d ws %zu)\n", n_in, out_size, ws_size); grid = -1; return; }
        int dev = 0, cus = 0, per_cu = 0;
        hipGetDevice(&dev);
        hipDeviceGetAttribute(&cus, hipDeviceAttributeMultiprocessorCount, dev);
        if (hipFuncSetAttribute((const void*)fwd_kernel, hipFuncAttributeMaxDynamicSharedMemorySize, LDS_BYTES) != hipSuccess) { fprintf(stderr, "hipFuncSetAttribute failed\n"); grid = -1; return; }
        hipOccupancyMaxActiveBlocksPerMultiprocessor(&per_cu, (const void*)fwd_kernel, NTHREADS, LDS_BYTES);
        if (per_cu < 1) per_cu = 1;
        if (per_cu > 1) per_cu = 1;
        grid = cus * per_cu;
    }
    if (grid < 0) return;
    hipMemsetAsync((char*)d_ws + WS_CTL, 0, 32768, stream);
    Params p{};
    for (int i = 0; i < 24; ++i) p.in[i] = (const float*)d_in[i];
    p.out = (float*)d_out; p.ws = (unsigned char*)d_ws;
#if ONE_LAUNCH
    p.ph_lo = 0; p.ph_hi = NPHASES;
    void* args[] = {&p};
    hipError_t e = hipLaunchCooperativeKernel((const void*)fwd_kernel, dim3(grid), dim3(NTHREADS), args, LDS_BYTES, stream);
    if (e != hipSuccess) fprintf(stderr, "cooperative launch failed: %s (grid %d)\n", hipGetErrorString(e), grid);
#else
    for (int ph = 0; ph < NPHASES; ++ph) {
        p.ph_lo = ph; p.ph_hi = ph + 1;
        hipLaunchKernelGGL(fwd_kernel, dim3(grid), dim3(NTHREADS), LDS_BYTES, stream, p);
    }
#endif
}
```
